# Optimizing an MI355X kernel written in HIP

```python
import math
import jax
import jax.numpy as jnp
from jax import lax
import numpy as np

D_MODEL = 1024
BATCH = 16
SEQ = 2048
DEPTH = 1
DEC_BATCH = 8
DEC_SEQ = 16
PAST_LEN = 2048

CHUNK = 64
LEFT_CHUNKS = 8
ATTN_REACH = LEFT_CHUNKS * CHUNK
D_SSM = D_MODEL // 2
D_ATTN = D_MODEL // 2
HEAD_DIM = 64
N_HEADS = D_ATTN // HEAD_DIM
MAX_REL = 128
N_REL = 2 * MAX_REL + 1
SSM_GROUP = 16
N_GROUPS = D_SSM // SSM_GROUP
SSM_STATE = 64
DT_MIN = 0.001
DT_MAX = 0.1
D_FF = ((8 * D_MODEL // 3 + 255) // 256) * 256
CONV_W = 3
D_IN = D_SSM + 3 * D_ATTN + 2 * D_MODEL
RMS_EPS = 1e-6
MASK_VALUE = -1e30

kernel_name = 'hybrid_s5_chunk_attn_convglu_stream_step'


def rms_norm(x, g):
    xf = x.astype(jnp.float32)
    y = xf * lax.rsqrt(jnp.mean(xf * xf, axis=-1, keepdims=True) + RMS_EPS)
    return (y * g.astype(jnp.float32)).astype(x.dtype)


def _linear_combine(left, right):
    a1, b1 = left
    a2, b2 = right
    return a1 * a2, a2 * b1 + b2


def s5_mixer(u, s0_re, s0_im, lam_re, lam_im, log_dt, b_re, b_im, c_re, c_im, d_skip):
    n, t, _ = u.shape
    f32 = jnp.float32
    uf = u.astype(f32).reshape(n, t, N_GROUPS, SSM_GROUP)
    lam = lax.complex(lam_re.astype(f32), lam_im.astype(f32))
    dt = jnp.exp(log_dt.astype(f32))[:, None]
    lam_bar = jnp.exp(lam * dt)
    b_mat = lax.complex(b_re.astype(f32), b_im.astype(f32))
    b_bar = ((lam_bar - 1.0) / lam)[..., None] * b_mat
    bu = jnp.einsum('ntgh,gph->ntgp', uf, b_bar)
    s0 = lax.complex(s0_re.astype(f32), s0_im.astype(f32))
    bu = bu.at[:, 0].add(lam_bar * s0)
    a = jnp.broadcast_to(lam_bar, (1, t) + lam_bar.shape)
    _, s = lax.associative_scan(_linear_combine, (a, bu), axis=1)
    c_mat = lax.complex(c_re.astype(f32), c_im.astype(f32))
    y = jnp.einsum('ntgp,ghp->ntgh', s, c_mat).real + d_skip.astype(f32) * uf
    s_last = s[:, -1]
    return y.reshape(n, t, D_SSM).astype(u.dtype), jnp.real(s_last), jnp.imag(s_last)


def rel_bias(table, q_off, k_off):
    rel = jnp.clip(q_off[:, None] - k_off[None, :], -MAX_REL, MAX_REL) + MAX_REL
    return table[:, rel].astype(jnp.float32)


def chunk_band_attention_prompt(q, k, v, table):
    n, s, h, dh = q.shape
    nc = s // CHUNK
    pad = LEFT_CHUNKS * CHUNK
    band = pad + CHUNK
    kp = jnp.pad(k, ((0, 0), (pad, 0), (0, 0), (0, 0)))
    vp = jnp.pad(v, ((0, 0), (pad, 0), (0, 0), (0, 0)))
    w = jnp.arange(band)
    bias = rel_bias(table, jnp.arange(CHUNK), w - pad)
    scale = HEAD_DIM ** -0.5

    def one_chunk(c):
        start = c * CHUNK
        qc = lax.dynamic_slice_in_dim(q, start, CHUNK, axis=1)
        kb = lax.dynamic_slice_in_dim(kp, start, band, axis=1)
        vb = lax.dynamic_slice_in_dim(vp, start, band, axis=1)
        sc = jnp.einsum('nihd,nkhd->nhik', qc, kb).astype(jnp.float32) * scale + bias
        valid = (start - pad + w) >= 0
        sc = jnp.where(valid, sc, MASK_VALUE)
        p = jax.nn.softmax(sc, axis=-1).astype(v.dtype)
        return jnp.einsum('nhik,nkhd->nihd', p, vb)

    out = lax.map(one_chunk, jnp.arange(nc))
    return out.transpose(1, 0, 2, 3, 4).reshape(n, s, h * dh)


def chunk_attention_sample(q, k, v, cache_k, cache_v, table):
    n, t, h, dh = q.shape
    w = cache_k.shape[1]
    kk = jnp.concatenate([cache_k.astype(k.dtype), k], axis=1)
    vv = jnp.concatenate([cache_v.astype(v.dtype), v], axis=1)
    k_off = jnp.concatenate([jnp.arange(w) - w, jnp.arange(t)])
    bias = rel_bias(table, jnp.arange(t), k_off)
    sc = jnp.einsum('nihd,nkhd->nhik', q, kk).astype(jnp.float32) * (HEAD_DIM ** -0.5) + bias
    p = jax.nn.softmax(sc, axis=-1).astype(v.dtype)
    return jnp.einsum('nhik,nkhd->nihd', p, vv).reshape(n, t, h * dh)


def causal_depthwise_conv(a, hist, taps, bias):
    t = a.shape[1]
    hp = jnp.concatenate([hist.astype(a.dtype), a], axis=1)
    y = bias
    for j in range(CONV_W):
        y = y + taps[j] * hp[:, j:j + t]
    return y, hp[:, hp.shape[1] - (CONV_W - 1):]


def hybrid_layer(x, ssm_re0, ssm_im0, past_k, past_v, conv_hist, p):
    n, t, _ = x.shape
    xn = rms_norm(x, p['g_mix'])
    z = xn @ p['w_in']
    cuts = [D_SSM, D_SSM + D_ATTN, D_SSM + 2 * D_ATTN, D_SSM + 3 * D_ATTN,
            D_SSM + 3 * D_ATTN + D_MODEL]
    u, q, k, v, g_ssm, g_att = jnp.split(z, cuts, axis=-1)
    y_ssm, s_re, s_im = s5_mixer(u, ssm_re0, ssm_im0, p['lam_re'], p['lam_im'], p['log_dt'],
                                 p['b_re'], p['b_im'], p['c_re'], p['c_im'], p['d'])
    gl = jax.nn.gelu(y_ssm) @ p['w_ssm_glu']
    br_ssm = gl[..., :D_MODEL] * jax.nn.sigmoid(gl[..., D_MODEL:])
    q = q.reshape(n, t, N_HEADS, HEAD_DIM)
    k = k.reshape(n, t, N_HEADS, HEAD_DIM)
    v = v.reshape(n, t, N_HEADS, HEAD_DIM)
    if past_k is None:
        att = chunk_band_attention_prompt(q, k, v, p['rel_bias'])
        keep = min(ATTN_REACH, t)
        new_k, new_v = k[:, t - keep:], v[:, t - keep:]
    else:
        att = chunk_attention_sample(q, k, v, past_k, past_v, p['rel_bias'])
        new_k, new_v = k, v
    br_att = att @ p['w_attn_up']
    mix = jax.nn.sigmoid(g_ssm) * br_ssm + jax.nn.sigmoid(g_att) * br_att
    h = x + mix @ p['w_o']
    hn = rms_norm(h, p['g_ffn'])
    up = hn @ p['w_up']
    a, b = jnp.split(up, [D_FF], axis=-1)
    c, new_conv = causal_depthwise_conv(a, conv_hist, p['conv_w'], p['conv_b'])
    out = h + (jax.nn.gelu(c) * b) @ p['w_down']
    return out, s_re, s_im, new_k, new_v, new_conv


def setup_inputs(seed: int = 0) -> dict:
    key = jax.random.key(seed)
    ks = jax.random.split(key, 32)
    f32 = jnp.float32

    def nrm(k, shape, s):
        return s * jax.random.normal(k, shape, f32)

    w_att = min(ATTN_REACH, PAST_LEN)
    n_idx = jnp.arange(SSM_STATE, dtype=f32)
    gp = (DEPTH, N_GROUPS, SSM_STATE)
    return {
        'x_prompt': nrm(ks[0], (BATCH, SEQ, D_MODEL), 1.0),
        'x_sample': nrm(ks[1], (DEC_BATCH, DEC_SEQ, D_MODEL), 1.0),
        'state_ssm_re': nrm(ks[2], (DEPTH, DEC_BATCH, N_GROUPS, SSM_STATE), 0.1),
        'state_ssm_im': nrm(ks[3], (DEPTH, DEC_BATCH, N_GROUPS, SSM_STATE), 0.1),
        'cache_attn_k': nrm(ks[4], (DEPTH, DEC_BATCH, w_att, N_HEADS, HEAD_DIM), 1.0),
        'cache_attn_v': nrm(ks[5], (DEPTH, DEC_BATCH, w_att, N_HEADS, HEAD_DIM), 1.0),
        'cache_conv': nrm(ks[6], (DEPTH, DEC_BATCH, CONV_W - 1, D_FF), 1.0),
        'g_mix': 1.0 + nrm(ks[7], (DEPTH, D_MODEL), 0.02),
        'w_in': nrm(ks[8], (DEPTH, D_MODEL, D_IN), D_MODEL ** -0.5),
        'ssm_lambda_re': -0.5 + nrm(ks[9], gp, 0.01),
        'ssm_lambda_im': math.pi * n_idx + nrm(ks[10], gp, 0.01),
        'ssm_log_dt': jax.random.uniform(ks[11], (DEPTH, N_GROUPS), dtype=f32,
                                         minval=math.log(DT_MIN), maxval=math.log(DT_MAX)),
        'ssm_b_re': nrm(ks[12], (DEPTH, N_GROUPS, SSM_STATE, SSM_GROUP), (2 * SSM_GROUP) ** -0.5),
        'ssm_b_im': nrm(ks[13], (DEPTH, N_GROUPS, SSM_STATE, SSM_GROUP), (2 * SSM_GROUP) ** -0.5),
        'ssm_c_re': nrm(ks[14], (DEPTH, N_GROUPS, SSM_GROUP, SSM_STATE), SSM_STATE ** -0.5),
        'ssm_c_im': nrm(ks[15], (DEPTH, N_GROUPS, SSM_GROUP, SSM_STATE), SSM_STATE ** -0.5),
        'ssm_d': nrm(ks[16], (DEPTH, N_GROUPS, SSM_GROUP), 1.0),
        'w_ssm_glu': nrm(ks[17], (DEPTH, D_SSM, 2 * D_MODEL), D_SSM ** -0.5),
        'attn_rel_bias': nrm(ks[18], (DEPTH, N_HEADS, N_REL), 0.1),
        'w_attn_up': nrm(ks[19], (DEPTH, D_ATTN, D_MODEL), D_ATTN ** -0.5),
        'w_o': nrm(ks[20], (DEPTH, D_MODEL, D_MODEL), D_MODEL ** -0.5),
        'g_ffn': 1.0 + nrm(ks[21], (DEPTH, D_MODEL), 0.02),
        'w_up': nrm(ks[22], (DEPTH, D_MODEL, 2 * D_FF), D_MODEL ** -0.5),
        'conv_w': nrm(ks[23], (DEPTH, CONV_W, D_FF), CONV_W ** -0.5),
        'conv_b': nrm(ks[24], (DEPTH, D_FF), 0.02),
        'w_down': nrm(ks[25], (DEPTH, D_FF, D_MODEL), D_FF ** -0.5),
        'g_final': 1.0 + nrm(ks[26], (D_MODEL,), 0.02),
    }


def reference(x_prompt, x_sample, state_ssm_re, state_ssm_im, cache_attn_k, cache_attn_v, cache_conv,
              g_mix, w_in, ssm_lambda_re, ssm_lambda_im, ssm_log_dt, ssm_b_re, ssm_b_im,
              ssm_c_re, ssm_c_im, ssm_d, w_ssm_glu, attn_rel_bias, w_attn_up, w_o,
              g_ffn, w_up, conv_w, conv_b, w_down, g_final):
    hp, hs = x_prompt, x_sample
    nb = x_prompt.shape[0]
    p_re, p_im, p_k, p_v, p_c = [], [], [], [], []
    s_re, s_im, s_k, s_v, s_c = [], [], [], [], []
    for l in range(DEPTH):
        prm = {
            'g_mix': g_mix[l], 'w_in': w_in[l],
            'lam_re': ssm_lambda_re[l], 'lam_im': ssm_lambda_im[l], 'log_dt': ssm_log_dt[l],
            'b_re': ssm_b_re[l], 'b_im': ssm_b_im[l], 'c_re': ssm_c_re[l], 'c_im': ssm_c_im[l],
            'd': ssm_d[l], 'w_ssm_glu': w_ssm_glu[l], 'rel_bias': attn_rel_bias[l],
            'w_attn_up': w_attn_up[l], 'w_o': w_o[l], 'g_ffn': g_ffn[l], 'w_up': w_up[l],
            'conv_w': conv_w[l], 'conv_b': conv_b[l], 'w_down': w_down[l],
        }
        zero_state = jnp.zeros((nb, N_GROUPS, SSM_STATE), jnp.float32)
        zero_conv = jnp.zeros((nb, CONV_W - 1, D_FF), x_prompt.dtype)
        hp, a_re, a_im, a_k, a_v, a_c = hybrid_layer(hp, zero_state, zero_state, None, None, zero_conv, prm)
        hs, b_re, b_im, b_k, b_v, b_c = hybrid_layer(hs, state_ssm_re[l], state_ssm_im[l],
                                                     cache_attn_k[l], cache_attn_v[l], cache_conv[l], prm)
        p_re.append(a_re); p_im.append(a_im); p_k.append(a_k); p_v.append(a_v); p_c.append(a_c)
        s_re.append(b_re); s_im.append(b_im); s_k.append(b_k); s_v.append(b_v); s_c.append(b_c)
    y_prompt = rms_norm(hp, g_final)
    y_sample = rms_norm(hs, g_final)
    new_ssm_re_prompt = jnp.stack(p_re)
    new_ssm_im_prompt = jnp.stack(p_im)
    new_k_prompt = jnp.stack(p_k)
    new_v_prompt = jnp.stack(p_v)
    new_conv_prompt = jnp.stack(p_c)
    new_ssm_re_sample = jnp.stack(s_re)
    new_ssm_im_sample = jnp.stack(s_im)
    new_k_sample = jnp.stack(s_k)
    new_v_sample = jnp.stack(s_v)
    new_conv_sample = jnp.stack(s_c)
    return (y_prompt, y_sample, new_ssm_re_prompt, new_ssm_im_prompt, new_k_prompt, new_v_prompt,
            new_conv_prompt, new_ssm_re_sample, new_ssm_im_sample, new_k_sample, new_v_sample,
            new_conv_sample)
```

```cpp
#include <hip/hip_runtime.h>
#include <hip/hip_cooperative_groups.h>
#include <cstdio>
#include <cstdint>
namespace cg = cooperative_groups;
namespace pg8 {
#define PG8_LAS __attribute__((address_space(3)))
typedef unsigned short bf16_t;
typedef short bf16x8 __attribute__((ext_vector_type(8)));
typedef float f32x4 __attribute__((ext_vector_type(4)));
typedef unsigned u32x4 __attribute__((ext_vector_type(4)));
constexpr int BM = 256, BK = 64, HALF = 128, HTB = HALF * BK * 2  , STAGE_BYTES = 8 * HTB, NXCD = 8, WGM = 4;

__host__ __device__ __forceinline__ int lds_byte(int r, int c) { const int st = (r >> 4) * 2 + (c >> 5), rr = r & 15, cc = c & 31, ob = rr * 64 + cc * 2; return st * 1024 + (ob ^ (((ob >> 9) & 1) << 5)); }
__host__ __device__ __forceinline__ void stage_rc(int b, int& R, int& C) { const int st = b / 1024, sb = b % 1024, swz = sb ^ (((sb >> 9) & 1) << 5); R = (st >> 1) * 16 + swz / 64; C = (st & 1) * 32 + (swz % 64) / 2; }
__host__ __device__ __forceinline__ int perm32(int rho) { const int n = rho >> 4, i = rho & 15; return 8 * (i >> 2) + 4 * n + (i & 3); }

struct Unit { int pm, pn, kc; };
struct Gemm { const bf16_t* A; const bf16_t* Bt; int M, N, K, ld; };

struct StaticOrder {
    int nM, nN, nwg, G, c;
    __host__ __device__ void init(int M, int N, int G_, int c_) { nM = M / BM; nN = N / BM; nwg = nM * nN; G = G_; c = c_; }
    __host__ __device__ bool next(int i, Unit& u) const {
        const long L = (long)i * G + c; if (L >= nwg) return false;
        int wgid = (int)L; { const int q = nwg / NXCD, r = nwg % NXCD, xcd = wgid % NXCD, off = wgid / NXCD; wgid = (xcd < r ? xcd * (q + 1) : r * (q + 1) + (xcd - r) * q) + off; }
        const int nig = WGM * nN, gid = wgid / nig, fm = gid * WGM, gsz = (nM - fm) < WGM ? (nM - fm) : WGM;
        u.pm = fm + ((wgid % nig) % gsz); u.pn = (wgid % nig) / gsz; u.kc = 0; return true;
    }
    __device__ __forceinline__ void a_ready(const Unit&) const {}
    __device__ __forceinline__ void done(const Unit&) const {}
};

struct PanelOrder {
    int nN, G, c, pm, nK;
    __host__ __device__ void init(int pm_, int N, int G_, int c_, int nK_ = 1) { nN = N / BM; G = G_; c = c_; pm = pm_; nK = nK_; }
    __host__ __device__ bool next(int i, Unit& u) const { const int L = i * G + c; if (L >= nN * nK) return false; u.pm = pm; u.pn = L % nN; u.kc = L / nN; return true; }
    __device__ __forceinline__ void a_ready(const Unit&) const {}
    __device__ __forceinline__ void done(const Unit&) const {}
};

typedef float f32x2_t __attribute__((ext_vector_type(2))); typedef __bf16 bf16x2_t __attribute__((ext_vector_type(2)));
__device__ __forceinline__ unsigned cvt_pk_bf16(float lo, float hi) { f32x2_t v = {lo, hi}; bf16x2_t b = __builtin_convertvector(v, bf16x2_t); return __builtin_bit_cast(unsigned, b); }
typedef float f32x2 __attribute__((ext_vector_type(2)));
template <class Epi, class Sched, bool ALIGN_EPI = false, bool SP2 = false, bool HALFM = false>
__device__ __forceinline__ void gemm_phase(PG8_LAS unsigned char* lds, const Gemm g, const Sched& S, const Epi& E) {
    const int tid = threadIdx.x, wid = __builtin_amdgcn_readfirstlane(tid >> 6), lane = tid & 63, wr = wid >> 2, wc = wid & 3, fr = lane & 15, fq = lane >> 4;
    const int K = g.ld, nt = g.K / BK;
    unsigned voffA[2], voffB[2];
#pragma unroll
    for (int i = 0; i < 2; ++i) { int R, C; stage_rc(tid * 16 + i * 8192, R, C); const int Rb = Epi::PERM ? ((R & ~31) + perm32(R & 31)) : R;
        voffA[i] = (unsigned)(R * K + C) * 2u; voffB[i] = (unsigned)(Rb * K + C) * 2u; }
    const size_t kstep = (size_t)(BK * 2);
    const size_t hstep = (size_t)HALF * K * 2;
    const size_t tstep = 2 * hstep;
    const unsigned ldsw = (unsigned)wid * 1024u;
    const int aoff = lds_byte(wr * 64 + fr, fq * 8), boff = lds_byte(wc * 32 + fr, fq * 8);
#define PG8_SA(b, h) (((b) * 2 + (h)) * HTB)
#define PG8_SB(b, h) ((4 + (b) * 2 + (h)) * HTB)
#define PG8_STAGE(bufoff, gbase, voff) do { _Pragma("unroll") for (int _i = 0; _i < 2; ++_i) \
        __builtin_amdgcn_global_load_lds((const unsigned*)((const char*)(gbase) + (voff)[_i]), (PG8_LAS unsigned*)(lds + (bufoff) + ldsw + _i * 8192), 16, 0, 0); } while (0)
#define PG8_LDA(dst, b, h) do { _Pragma("unroll") for (int m = 0; m < 4; ++m) _Pragma("unroll") for (int k = 0; k < 2; ++k) dst[m][k] = *(const PG8_LAS bf16x8*)(lds + PG8_SA(b, h) + aoff + m * 2048 + k * 1024); } while (0)
#define PG8_LDB(dst, b, h) do { _Pragma("unroll") for (int n = 0; n < 2; ++n) _Pragma("unroll") for (int k = 0; k < 2; ++k) dst[n][k] = *(const PG8_LAS bf16x8*)(lds + PG8_SB(b, h) + boff + n * 2048 + k * 1024); } while (0)
#define PG8_MMA(ai, bj, At, Bt) do { __builtin_amdgcn_s_setprio(1); _Pragma("unroll") for (int m = 0; m < 4; ++m) _Pragma("unroll") for (int n = 0; n < 2; ++n) _Pragma("unroll") for (int k = 0; k < 2; ++k) \
        acc[ai][bj][m][n] = __builtin_amdgcn_mfma_f32_16x16x32_bf16(Bt[n][k], At[m][k], acc[ai][bj][m][n], 0, 0, 0); __builtin_amdgcn_s_setprio(0); } while (0)
#define PG8_WAIT_V(n) asm volatile("s_waitcnt vmcnt(" #n ")" ::: "memory")
#define PG8_WAIT_L(n) asm volatile("s_waitcnt lgkmcnt(" #n ")" ::: "memory")
#define PG8_BAR __builtin_amdgcn_s_barrier()
#define PG8_SCHED __builtin_amdgcn_sched_barrier(0)
    Unit cur, nxt; int ui = 0;
    if (!S.next(0, cur)) return;
    f32x4 acc[2][2][4][2];
#pragma unroll
    for (int a = 0; a < 2; ++a)
#pragma unroll
        for (int b = 0; b < 2; ++b)
#pragma unroll
            for (int m = 0; m < 4; ++m)
#pragma unroll
                for (int n = 0; n < 2; ++n) acc[a][b][m][n] = (f32x4){0.f, 0.f, 0.f, 0.f};
    bf16x8 At[4][2], B0[2][2], B1[2][2];
    const char* cA = (const char*)g.A + (size_t)cur.pm * tstep + (size_t)cur.kc * g.K * 2; const char* cB = (const char*)g.Bt + (size_t)cur.pn * tstep + (size_t)cur.kc * g.K * 2;
    S.a_ready(cur);
    if constexpr (SP2) {
        PG8_STAGE(PG8_SB(0, 0), cB, voffB); PG8_STAGE(PG8_SB(0, 1), cB + hstep, voffB); PG8_STAGE(PG8_SA(0, 0), cA, voffA); PG8_STAGE(PG8_SA(0, 1), cA + hstep, voffA);
        if (wr == 1) PG8_BAR;
        PG8_WAIT_V(2); PG8_BAR;
        PG8_STAGE(PG8_SB(1, 0), cB + kstep, voffB); PG8_STAGE(PG8_SA(1, 0), cA + kstep, voffA); PG8_STAGE(PG8_SB(1, 1), cB + hstep + kstep, voffB);
        PG8_WAIT_V(6); PG8_BAR;
    } else {
        PG8_STAGE(PG8_SB(0, 0), cB, voffB); PG8_STAGE(PG8_SA(0, 0), cA, voffA); PG8_STAGE(PG8_SB(0, 1), cB + hstep, voffB); PG8_STAGE(PG8_SA(0, 1), cA + hstep, voffA);
        if (wr == 1) PG8_BAR;
        PG8_WAIT_V(4); PG8_BAR;
        PG8_STAGE(PG8_SB(1, 0), cB + kstep, voffB); PG8_STAGE(PG8_SA(1, 0), cA + kstep, voffA); PG8_STAGE(PG8_SB(1, 1), cB + hstep + kstep, voffB);
        PG8_WAIT_V(6); PG8_BAR;
    }
    for (;;) {
        const bool has_next = S.next(ui + 1, nxt);
        const char* nA = has_next ? (const char*)g.A + (size_t)nxt.pm * tstep + (size_t)nxt.kc * g.K * 2 : cA; const char* nB = has_next ? (const char*)g.Bt + (size_t)nxt.pn * tstep + (size_t)nxt.kc * g.K * 2 : cB;
        for (int t = 0; t < nt; t += 2) {
            const bool last = (t == nt - 2);
            const char* a1 = cA + (size_t)(t + 1) * kstep;
            const char* a2 = last ? nA : cA + (size_t)(t + 2) * kstep; const char* b2 = last ? nB : cB + (size_t)(t + 2) * kstep;
            const char* a3 = a2 + kstep; const char* b3 = b2 + kstep;
            if (last && has_next) S.a_ready(nxt);
            if constexpr (SP2) {
            PG8_LDB(B0, 0, 0); PG8_LDB(B1, 0, 1); PG8_SCHED; PG8_LDA(At, 0, 0); PG8_STAGE(PG8_SA(1, 1), a1 + hstep, voffA);
            PG8_WAIT_V(8); PG8_WAIT_L(0); PG8_BAR; PG8_MMA(0, 0, At, B0); PG8_MMA(0, 1, At, B1); PG8_BAR; PG8_SCHED;
            if constexpr (!HALFM) PG8_LDA(At, 0, 1); PG8_STAGE(PG8_SB(0, 0), b2, voffB); PG8_STAGE(PG8_SB(0, 1), b2 + hstep, voffB); PG8_STAGE(PG8_SA(0, 0), a2, voffA);
            PG8_WAIT_V(8); PG8_WAIT_L(0); PG8_BAR; if constexpr (!HALFM) { PG8_MMA(1, 0, At, B0); PG8_MMA(1, 1, At, B1); } PG8_BAR; PG8_SCHED;
            PG8_LDB(B0, 1, 0); PG8_LDB(B1, 1, 1); PG8_SCHED; PG8_LDA(At, 1, 0); PG8_STAGE(PG8_SA(0, 1), a2 + hstep, voffA);
            PG8_WAIT_V(8); PG8_WAIT_L(0); PG8_BAR; PG8_MMA(0, 0, At, B0); PG8_MMA(0, 1, At, B1); PG8_BAR; PG8_SCHED;
            if constexpr (!HALFM) PG8_LDA(At, 1, 1); PG8_STAGE(PG8_SB(1, 0), b3, voffB); PG8_STAGE(PG8_SB(1, 1), b3 + hstep, voffB); PG8_STAGE(PG8_SA(1, 0), a3, voffA);
            PG8_WAIT_V(8); PG8_WAIT_L(0); PG8_BAR; if constexpr (!HALFM) { PG8_MMA(1, 0, At, B0); PG8_MMA(1, 1, At, B1); } PG8_BAR; PG8_SCHED;
            } else {
            PG8_LDB(B0, 0, 0); PG8_SCHED; PG8_LDA(At, 0, 0); PG8_STAGE(PG8_SA(1, 1), a1 + hstep, voffA);
            PG8_WAIT_L(8); PG8_BAR; PG8_WAIT_L(0); PG8_MMA(0, 0, At, B0); PG8_BAR; PG8_SCHED;
            PG8_LDB(B1, 0, 1); PG8_STAGE(PG8_SB(0, 0), b2, voffB);
            PG8_BAR; PG8_WAIT_L(0); PG8_MMA(0, 1, At, B1); PG8_BAR;
            PG8_LDA(At, 0, 1); PG8_STAGE(PG8_SA(0, 0), a2, voffA);
            PG8_BAR; PG8_WAIT_L(0); PG8_MMA(1, 0, At, B0); PG8_BAR; PG8_SCHED;
            PG8_STAGE(PG8_SB(0, 1), b2 + hstep, voffB);
            PG8_WAIT_V(6); PG8_BAR; PG8_MMA(1, 1, At, B1); PG8_BAR;
            PG8_LDB(B0, 1, 0); PG8_SCHED; PG8_LDA(At, 1, 0); PG8_STAGE(PG8_SA(0, 1), a2 + hstep, voffA);
            PG8_WAIT_L(8); PG8_BAR; PG8_WAIT_L(0); PG8_MMA(0, 0, At, B0); PG8_BAR; PG8_SCHED;
            PG8_LDB(B1, 1, 1); PG8_STAGE(PG8_SB(1, 0), b3, voffB);
            PG8_BAR; PG8_WAIT_L(0); PG8_MMA(0, 1, At, B1); PG8_BAR;
            PG8_LDA(At, 1, 1); PG8_STAGE(PG8_SA(1, 0), a3, voffA);
            PG8_BAR; PG8_WAIT_L(0); PG8_MMA(1, 0, At, B0); PG8_BAR; PG8_SCHED;
            PG8_STAGE(PG8_SB(1, 1), b3 + hstep, voffB);
            PG8_WAIT_V(6); PG8_BAR; PG8_MMA(1, 1, At, B1); PG8_BAR;
            }
        }
        if constexpr (ALIGN_EPI) { if (wr == 0) PG8_BAR; }
        if constexpr (!Epi::AFTER_DRAIN) { int fr_ = fr, fq_ = fq; asm volatile("" : "+v"(fr_), "+v"(fq_));
            E(acc, cur, wr, wc, fr_, fq_); S.done(cur); }
        if (!has_next) break;
#pragma unroll
        for (int a = 0; a < 2; ++a)
#pragma unroll
            for (int b = 0; b < 2; ++b)
#pragma unroll
                for (int m = 0; m < 4; ++m)
#pragma unroll
                    for (int n = 0; n < 2; ++n) acc[a][b][m][n] = (f32x4){0.f, 0.f, 0.f, 0.f};
        cur = nxt; cA = nA; cB = nB; ++ui;
        if constexpr (ALIGN_EPI) { if (wr == 1) PG8_BAR; }
    }
    PG8_WAIT_V(0);
    if constexpr (!ALIGN_EPI) { if (wr == 0) PG8_BAR; }
    PG8_BAR;
    if constexpr (Epi::AFTER_DRAIN) { E.fused(acc, cur, wr, wc, fr, fq, lds, wid, lane); S.done(cur); }
#undef PG8_SA
#undef PG8_SB
#undef PG8_STAGE
#undef PG8_LDA
#undef PG8_LDB
#undef PG8_MMA
#undef PG8_WAIT_V
#undef PG8_WAIT_L
#undef PG8_BAR
#undef PG8_SCHED
}
}
#ifndef MK_N_LAUNCHES
#define MK_N_LAUNCHES 1
#endif
#define LAS __attribute__((address_space(3)))
typedef unsigned short bf16_t;
typedef short bf16x8 __attribute__((ext_vector_type(8)));
typedef float f32x4 __attribute__((ext_vector_type(4)));
typedef float f32x16 __attribute__((ext_vector_type(16)));
typedef unsigned u32x4 __attribute__((ext_vector_type(4)));
typedef unsigned u32x2 __attribute__((ext_vector_type(2)));
using pg8::cvt_pk_bf16;

constexpr int DM = 1024, NB = 16, SEQ = 2048, SBT = 8, STT = 16;
constexpr int MP = NB * SEQ, MS = SBT * STT, MR = MP + MS, MT = 33024, NPAN = MT / 256;
constexpr int DFF = 2816, DIN = 4096, NG = 32;
constexpr float RMS_EPS = 1e-6f;
constexpr float LOG2E = 1.4426950408889634f;
constexpr float QSCALE = 0.125f * LOG2E;
constexpr size_t O_YP = 0, O_YS = O_YP + (size_t)MP * DM, O_SREP = O_YS + (size_t)MS * DM, O_SIMP = O_SREP + NB * 32 * 64, O_KP = O_SIMP + NB * 32 * 64,
                 O_VP = O_KP + (size_t)NB * 512 * 512, O_CP = O_VP + (size_t)NB * 512 * 512, O_SRES = O_CP + NB * 2 * DFF, O_SIMS = O_SRES + SBT * 32 * 64,
                 O_KS = O_SIMS + SBT * 32 * 64, O_VS = O_KS + MS * 512, O_CS = O_VS + MS * 512, O_END = O_CS + SBT * 2 * DFF;
constexpr size_t MiB = 1u << 20;
constexpr size_t WS_CTL = 0, CTL_BYTES = 1 * MiB;
constexpr size_t CTL_BAR = 768 * 1024;
constexpr size_t CTL_SSQ2 = 4096, CTL_SSQ3 = 4096 + 256 * 1024;
constexpr size_t WS_WIN = 1 * MiB, WS_WGLU = 9 * MiB, WS_WAU = 11 * MiB, WS_WO = 12 * MiB, WS_WUP = 14 * MiB, WS_WDN = 25 * MiB;
constexpr size_t WS_BBAR = 31 * MiB, WS_CMAT = WS_BBAR + 131072, WS_LAMB = WS_CMAT + 131072;
constexpr size_t WS_XN = 32 * MiB;
constexpr size_t WS_U = 97 * MiB, WS_Q = 130 * MiB, WS_KB = 163 * MiB, WS_VT = 196 * MiB, WS_SG = 229 * MiB, WS_SA = 294 * MiB, WS_YS = 359 * MiB, WS_ATT = 392 * MiB;
constexpr size_t WS_HB = 97 * MiB;
constexpr size_t WS_G = 163 * MiB;
constexpr size_t WS_HALO = 425 * MiB, WS_SIDEA = 437 * MiB, WS_SIDEB = 449 * MiB, WS_END = 461 * MiB;
static_assert(WS_G + (size_t)MT * DFF * 2 <= WS_YS && WS_HB + (size_t)MT * DM * 2 <= WS_KB && WS_XN + (size_t)MT * DM * 2 <= WS_U, "ws map");
static_assert(CTL_SSQ3 + MT * 4 <= CTL_BYTES && (size_t)516 * 2 * DFF * 4 <= 12 * MiB, "ws map 2");
constexpr int LDS_BYTES = 147456;

__device__ __forceinline__ float bf2f(unsigned short b) { return __uint_as_float(((unsigned)b) << 16); }
__device__ __forceinline__ float bflo(unsigned w) { return __uint_as_float(w << 16); }
__device__ __forceinline__ float bfhi(unsigned w) { return __uint_as_float(w & 0xffff0000u); }
__device__ __forceinline__ float ex2(float x) { return __builtin_amdgcn_exp2f(x); }
__device__ __forceinline__ float sigm(float x) { return __builtin_amdgcn_rcpf(1.f + ex2(-LOG2E * x)); }
__device__ __forceinline__ float gelu_t(float x) { const float z = 1.5957691216057308f * (x + 0.044715f * x * x * x); return x * sigm(z); }
__device__ __forceinline__ float* hrow(float* out, int row) { return row < MP ? out + O_YP + (size_t)row * DM : out + O_YS + (size_t)(row - MP) * DM; }

#define ACC_T const f32x4 (&acc)[2][2][4][2]
#define EPI_STATICS static constexpr bool PERM = true, AFTER_DRAIN = false;
__device__ __forceinline__ u32x4 pack8(const f32x4 a, const f32x4 b) { u32x4 w; w.x = cvt_pk_bf16(a[0], a[1]); w.y = cvt_pk_bf16(a[2], a[3]); w.z = cvt_pk_bf16(b[0], b[1]); w.w = cvt_pk_bf16(b[2], b[3]); return w; }

struct EpiIn {
    EPI_STATICS
    bf16_t *U, *Q, *KB, *VT, *SG, *SA; float* out;
    __device__ __forceinline__ void operator()(ACC_T, const pg8::Unit& u, int wr, int wc, int fr, int fq) const {
        const int pn = u.pn;
#pragma unroll
        for (int ai = 0; ai < 2; ++ai)
#pragma unroll
            for (int m = 0; m < 4; ++m) {
                const int row = u.pm * 256 + ai * 128 + wr * 64 + m * 16 + fr;
                if (row >= MR) continue;
#pragma unroll
                for (int bj = 0; bj < 2; ++bj) {
                    const int c = pn * 256 + bj * 128 + wc * 32 + 8 * fq;
                    f32x4 v0 = acc[ai][bj][m][0], v1 = acc[ai][bj][m][1];
                    if (pn < 2) { *(u32x4*)(U + ((size_t)(c >> 4) * MT + row) * 16 + (c & 8)) = pack8(v0, v1); }
                    else if (pn < 4) { *(u32x4*)(Q + (size_t)row * 512 + (c - 512)) = pack8(v0 * QSCALE, v1 * QSCALE); }
                    else if (pn < 8) {
                        const bool isv = pn >= 6; const int cc = c - (isv ? 1536 : 1024);
                        float* fo = nullptr;
                        if (row >= MP) fo = out + (isv ? O_VS : O_KS) + (size_t)(row - MP) * 512 + cc;
                        else { const int t = row & 2047, nb = row >> 11; if (t >= 1536) fo = out + (isv ? O_VP : O_KP) + ((size_t)(nb * 512 + t - 1536)) * 512 + cc; }
                        if (fo) { *(f32x4*)fo = v0; *(f32x4*)(fo + 4) = v1; }
                        if (!isv) {
                            if (row < MP) { const int t = row & 2047, nb = row >> 11, hh = cc >> 6, dch = (cc & 63) >> 3, kl = t & 31, pos = (kl & ~12) | ((kl & 4) << 1) | ((kl & 8) >> 1);
                                *(u32x4*)(KB + (((size_t)(nb * 8 + hh) * 64 + (t >> 5)) * 8 + dch) * 256 + pos * 8) = pack8(v0, v1); } }
                        else if (row < MP) {
                            const int t = row & 2047, nb = row >> 11, hh = cc >> 6, d = cc & 63;
                            bf16_t* vp = VT + ((size_t)(nb * 8 + hh) * 64 + (t >> 5)) * 2048 + (((d >> 5) * 2 + ((t >> 4) & 1)) * 2 + ((t >> 3) & 1)) * 256 + (d & 31) * 8 + (t & 7);
                            const u32x4 w = pack8(v0, v1);
                            vp[0] = (bf16_t)(w.x & 0xffff); vp[8] = (bf16_t)(w.x >> 16); vp[16] = (bf16_t)(w.y & 0xffff); vp[24] = (bf16_t)(w.y >> 16);
                            vp[32] = (bf16_t)(w.z & 0xffff); vp[40] = (bf16_t)(w.z >> 16); vp[48] = (bf16_t)(w.w & 0xffff); vp[56] = (bf16_t)(w.w >> 16);
                        }
                    } else {
                        bf16_t* dst = (pn < 12) ? SG + (size_t)row * 1024 + (c - 2048) : SA + (size_t)row * 1024 + (c - 3072);
#pragma unroll
                        for (int e = 0; e < 4; ++e) { v0[e] = sigm(v0[e]); v1[e] = sigm(v1[e]); }
                        *(u32x4*)dst = pack8(v0, v1);
                    }
                }
            }
    }
};

struct EpiAttUp {
    EPI_STATICS
    const bf16_t* SA; bf16_t* T1;
    __device__ __forceinline__ void operator()(ACC_T, const pg8::Unit& u, int wr, int wc, int fr, int fq) const {
#pragma unroll
        for (int ai = 0; ai < 2; ++ai)
#pragma unroll
            for (int m = 0; m < 4; ++m) {
                const int row = u.pm * 256 + ai * 128 + wr * 64 + m * 16 + fr;
                if (row >= MR) continue;
#pragma unroll
                for (int bj = 0; bj < 2; ++bj) {
                    const size_t off = (size_t)row * 1024 + u.pn * 256 + bj * 128 + wc * 32 + 8 * fq;
                    const u32x4 s = *(const u32x4*)(SA + off);
                    f32x4 v0 = acc[ai][bj][m][0], v1 = acc[ai][bj][m][1];
                    v0[0] *= bflo(s.x); v0[1] *= bfhi(s.x); v0[2] *= bflo(s.y); v0[3] *= bfhi(s.y);
                    v1[0] *= bflo(s.z); v1[1] *= bfhi(s.z); v1[2] *= bflo(s.w); v1[3] *= bfhi(s.w);
                    *(u32x4*)(T1 + off) = pack8(v0, v1);
                }
            }
    }
};

struct EpiGlu {
    EPI_STATICS
    const bf16_t* SG; bf16_t* MIX;
    __device__ __forceinline__ void operator()(ACC_T, const pg8::Unit& u, int wr, int wc, int fr, int fq) const {
#pragma unroll
        for (int ai = 0; ai < 2; ++ai)
#pragma unroll
            for (int m = 0; m < 4; ++m) {
                const int row = u.pm * 256 + ai * 128 + wr * 64 + m * 16 + fr;
                if (row >= MR) continue;
                const size_t off = (size_t)row * 1024 + u.pn * 128 + wc * 32 + 8 * fq;
                const u32x4 s = *(const u32x4*)(SG + off), t = *(const u32x4*)(MIX + off);
                f32x4 v0 = acc[ai][0][m][0], v1 = acc[ai][0][m][1]; const f32x4 g0 = acc[ai][1][m][0], g1 = acc[ai][1][m][1];
#pragma unroll
                for (int e = 0; e < 4; ++e) { v0[e] *= sigm(g0[e]); v1[e] *= sigm(g1[e]); }
                v0[0] = bflo(t.x) + bflo(s.x) * v0[0]; v0[1] = bfhi(t.x) + bfhi(s.x) * v0[1]; v0[2] = bflo(t.y) + bflo(s.y) * v0[2]; v0[3] = bfhi(t.y) + bfhi(s.y) * v0[3];
                v1[0] = bflo(t.z) + bflo(s.z) * v1[0]; v1[1] = bfhi(t.z) + bfhi(s.z) * v1[1]; v1[2] = bflo(t.w) + bflo(s.w) * v1[2]; v1[3] = bfhi(t.w) + bfhi(s.w) * v1[3];
                *(u32x4*)(MIX + off) = pack8(v0, v1);
            }
    }
};

template <bool FIRST> struct EpiRes {
    EPI_STATICS
    const float *xp, *xs; float* out; bf16_t* HB; float* ssq;
    __device__ __forceinline__ void operator()(ACC_T, const pg8::Unit& u, int wr, int wc, int fr, int fq) const {
#pragma unroll
        for (int ai = 0; ai < 2; ++ai)
#pragma unroll
            for (int m = 0; m < 4; ++m) {
                const int row = u.pm * 256 + ai * 128 + wr * 64 + m * 16 + fr;
                float sq = 0.f;
                if (row < MR) {
                    float* hp = hrow(out, row);
                    const float* bp = FIRST ? (row < MP ? xp + (size_t)row * DM : xs + (size_t)(row - MP) * DM) : hp;
#pragma unroll
                    for (int bj = 0; bj < 2; ++bj) {
                        const int c = u.pn * 256 + bj * 128 + wc * 32 + 8 * fq;
                        const f32x4 h0 = *(const f32x4*)(bp + c) + acc[ai][bj][m][0], h1 = *(const f32x4*)(bp + c + 4) + acc[ai][bj][m][1];
                        *(f32x4*)(hp + c) = h0; *(f32x4*)(hp + c + 4) = h1;
                        if (FIRST) *(u32x4*)(HB + (size_t)row * DM + c) = pack8(h0, h1);
                        sq += (h0[0] * h0[0] + h0[1] * h0[1]) + (h0[2] * h0[2] + h0[3] * h0[3]) + (h1[0] * h1[0] + h1[1] * h1[1]) + (h1[2] * h1[2] + h1[3] * h1[3]);
                    }
                }
                if (FIRST) { sq += __shfl_xor(sq, 16); sq += __shfl_xor(sq, 32); if (fq == 0 && row < MR) unsafeAtomicAdd(ssq + row, sq); }
            }
    }
};

struct EpiAddSample {
    EPI_STATICS
    float* out;
    __device__ __forceinline__ void operator()(ACC_T, const pg8::Unit& u, int wr, int wc, int fr, int fq) const {
#pragma unroll
        for (int m = 0; m < 4; ++m) {
            const int row = u.pm * 256 + wr * 64 + m * 16 + fr;
            float* hp = hrow(out, row);
#pragma unroll
            for (int bj = 0; bj < 2; ++bj) {
                const int c = u.pn * 256 + bj * 128 + wc * 32 + 8 * fq;
#pragma unroll
                for (int e = 0; e < 4; ++e) { unsafeAtomicAdd(hp + c + e, acc[0][bj][m][0][e]); unsafeAtomicAdd(hp + c + 4 + e, acc[0][bj][m][1][e]); }
            }
        }
    }
};

struct EpiUp {
    EPI_STATICS
    bf16_t* G; float *HALO, *SIDEA, *SIDEB; const float *ssq, *taps, *cbias, *cconv; float* out;
    static __device__ __forceinline__ float dpp_shr1(float old, float v) { return __builtin_bit_cast(float, __builtin_amdgcn_update_dpp(__builtin_bit_cast(int, old), __builtin_bit_cast(int, v), 0x111, 0xf, 0xf, false)); }
    static __device__ __forceinline__ float dpp_shr2(float old, float v) { return __builtin_bit_cast(float, __builtin_amdgcn_update_dpp(__builtin_bit_cast(int, old), __builtin_bit_cast(int, v), 0x112, 0xf, 0xf, false)); }
    static __device__ __forceinline__ float dpp_ror1(float v) { return __builtin_bit_cast(float, __builtin_amdgcn_update_dpp(0, __builtin_bit_cast(int, v), 0x121, 0xf, 0xf, false)); }
    static __device__ __forceinline__ float dpp_ror2(float v) { return __builtin_bit_cast(float, __builtin_amdgcn_update_dpp(0, __builtin_bit_cast(int, v), 0x122, 0xf, 0xf, false)); }
    __device__ __forceinline__ void operator()(ACC_T, const pg8::Unit& u, int wr, int wc, int fr, int fq) const {
        const int pm = u.pm; const bool samp = (pm == NPAN - 1);
        const int c0 = u.pn * 128 + wc * 32 + 8 * fq;
        f32x4 t0[2], t1[2], t2[2], cb[2];
#pragma unroll
        for (int n = 0; n < 2; ++n) { t0[n] = *(const f32x4*)(taps + c0 + 4 * n); t1[n] = *(const f32x4*)(taps + DFF + c0 + 4 * n); t2[n] = *(const f32x4*)(taps + 2 * DFF + c0 + 4 * n); cb[n] = *(const f32x4*)(cbias + c0 + 4 * n); }
#pragma unroll
        for (int ai = 0; ai < 2; ++ai) {
            float rs[4];
#pragma unroll
            for (int m = 0; m < 4; ++m) rs[m] = 1.0f / sqrtf(ssq[pm * 256 + ai * 128 + wr * 64 + m * 16 + fr] * (1.0f / DM) + RMS_EPS);
            f32x4 prev[2] = {(f32x4){0.f, 0.f, 0.f, 0.f}, (f32x4){0.f, 0.f, 0.f, 0.f}};
#pragma unroll
            for (int m = 0; m < 4; ++m) {
                const int row = pm * 256 + ai * 128 + wr * 64 + m * 16 + fr;
                f32x4 g[2], av[2], bv[2];
#pragma unroll
                for (int n = 0; n < 2; ++n) {
                    av[n] = acc[ai][0][m][n] * rs[m]; bv[n] = acc[ai][1][m][n] * rs[m];
                    if (samp) { prev[n] = (f32x4){0.f, 0.f, 0.f, 0.f}; if (ai == 0 && fr >= 14) prev[n] = *(const f32x4*)(cconv + ((size_t)(4 * wr + m) * 2 + (fr - 14)) * DFF + c0 + 4 * n); }
#pragma unroll
                    for (int e = 0; e < 4; ++e) {
                        const float a1 = dpp_shr1(dpp_ror1(prev[n][e]), av[n][e]), a2 = dpp_shr2(dpp_ror2(prev[n][e]), av[n][e]);
                        g[n][e] = gelu_t(cb[n][e] + t0[n][e] * a2 + t1[n][e] * a1 + t2[n][e] * av[n][e]) * bv[n][e];
                    }
                    prev[n] = av[n];
                }
                if (row < MR) *(u32x4*)(G + (size_t)row * DFF + c0) = pack8(g[0], g[1]);
                if (!samp) {
                    const int blk = row >> 6;
                    if (m == 0 && fr < 2) {
#pragma unroll
                        for (int n = 0; n < 2; ++n) { *(f32x4*)(SIDEA + ((size_t)blk * 2 + fr) * DFF + c0 + 4 * n) = av[n]; *(f32x4*)(SIDEB + ((size_t)blk * 2 + fr) * DFF + c0 + 4 * n) = bv[n]; } }
                    if (m == 3 && fr >= 14) {
#pragma unroll
                        for (int n = 0; n < 2; ++n) *(f32x4*)(HALO + ((size_t)blk * 2 + (fr - 14)) * DFF + c0 + 4 * n) = av[n]; }
                } else if (ai == 0 && fr >= 14) {
#pragma unroll
                    for (int n = 0; n < 2; ++n) *(f32x4*)(out + O_CS + ((size_t)(4 * wr + m) * 2 + (fr - 14)) * DFF + c0 + 4 * n) = av[n]; }
            }
        }
    }
};
__device__ __forceinline__ unsigned f2bf(float f) { unsigned u = __builtin_bit_cast(unsigned, f); return (u + 0x7fffu + ((u >> 16) & 1u)) >> 16; }
__device__ __forceinline__ unsigned pk2(float lo, float hi) { return f2bf(lo) | (f2bf(hi) << 16); }
__device__ __forceinline__ float wave_sum(float v) {
#pragma unroll
    for (int o = 1; o < 64; o <<= 1) v += __shfl_xor(v, o);
    return v;
}
__device__ __forceinline__ void p0_transpose_item(const float* W, int K, int N, bf16_t* WT, LAS float* scr, int item, int lane, const float* g, bool ilv) {
    const int nblk = N / 32, kb = item / nblk, nb = item % nblk, k0 = 64 * kb, n0 = 32 * nb;
    {
        const int r8 = lane >> 3, c4 = (lane & 7) * 4;
        f32x4 v[8];
#pragma unroll
        for (int i = 0; i < 8; ++i) v[i] = *(const f32x4*)(W + (size_t)(k0 + 8 * i + r8) * N + n0 + c4);
#pragma unroll
        for (int i = 0; i < 8; ++i) { const int kk = 8 * i + r8; if (g) v[i] = v[i] * g[k0 + kk];
            scr[kk * 33 + c4] = v[i][0]; scr[kk * 33 + c4 + 1] = v[i][1]; scr[kk * 33 + c4 + 2] = v[i][2]; scr[kk * 33 + c4 + 3] = v[i][3]; }
    }
    asm volatile("s_waitcnt lgkmcnt(0)" ::: "memory");
    int d0 = n0;
    if (ilv) { const int hn = N / 2; d0 = (n0 < hn) ? 256 * (n0 / 128) + (n0 % 128) : 256 * ((n0 - hn) / 128) + 128 + ((n0 - hn) % 128); }
    const int c = lane & 7;
#pragma unroll
    for (int j = 0; j < 4; ++j) { const int n = (lane >> 3) + 8 * j; const LAS float* s = scr + (8 * c) * 33 + n;
        u32x4 o; o.x = pk2(s[0 * 33], s[1 * 33]); o.y = pk2(s[2 * 33], s[3 * 33]); o.z = pk2(s[4 * 33], s[5 * 33]); o.w = pk2(s[6 * 33], s[7 * 33]);
        *(u32x4*)(WT + (size_t)(d0 + n) * K + k0 + 8 * c) = o; }
    asm volatile("s_waitcnt lgkmcnt(0)" ::: "memory");
}
__device__ __forceinline__ void sincos_d(double x, double& s, double& c) {
    const double TWO_PI = 6.283185307179586476925287, INV = 0.159154943091895335768884;
    const double k = __builtin_rint(x * INV); double r = __builtin_fma(-k, TWO_PI, x); r = __builtin_fma(-k, -2.4492935982947064e-16, r);
    const double r2 = r * r; double ts = 1.0, tc = 1.0, ss = 1.0, cc = 1.0;
#pragma unroll
    for (int i = 1; i <= 14; ++i) { tc = -tc * r2 / (double)((2 * i - 1) * (2 * i)); cc += tc; ts = -ts * r2 / (double)((2 * i) * (2 * i + 1)); ss += ts; }
    s = r * ss; c = cc;
}
__device__ __forceinline__ double exp_small_d(double x) {
    double t = 1.0, acc = 1.0;
#pragma unroll
    for (int i = 1; i <= 12; ++i) { t = t * x / (double)i; acc += t; }
    return acc;
}
struct P {
    const float* in[27]; float* out; unsigned char* ws;
};
__device__ __forceinline__ void p0_prologue(const P& p, LAS unsigned char* lds, int vb, int G, int wave, int lane) {
    LAS float* scr = (LAS float*)(lds + wave * 16384);
    const int gw = vb * 8 + wave, NGW = G * 8;
    unsigned char* ws = p.ws;
    constexpr int I_IN = 16 * 128, I_GLU = 8 * 64, I_AU = 8 * 32, I_O = 16 * 32, I_UP = 16 * 176, I_DN = 44 * 32;
    constexpr int NITEMS = I_IN + I_GLU + I_AU + I_O + I_UP + I_DN;
    for (int it = gw; it < NITEMS; it += NGW) {
        int r = it;
        if (r < I_IN) { p0_transpose_item(p.in[8], 1024, 4096, (bf16_t*)(ws + WS_WIN), scr, r, lane, nullptr, false); continue; } r -= I_IN;
        if (r < I_GLU) { p0_transpose_item(p.in[17], 512, 2048, (bf16_t*)(ws + WS_WGLU), scr, r, lane, nullptr, true); continue; } r -= I_GLU;
        if (r < I_AU) { p0_transpose_item(p.in[19], 512, 1024, (bf16_t*)(ws + WS_WAU), scr, r, lane, nullptr, false); continue; } r -= I_AU;
        if (r < I_O) { p0_transpose_item(p.in[20], 1024, 1024, (bf16_t*)(ws + WS_WO), scr, r, lane, nullptr, false); continue; } r -= I_O;
        if (r < I_UP) { p0_transpose_item(p.in[22], 1024, 5632, (bf16_t*)(ws + WS_WUP), scr, r, lane, p.in[21], true); continue; } r -= I_UP;
        p0_transpose_item(p.in[25], 2816, 1024, (bf16_t*)(ws + WS_WDN), scr, r, lane, nullptr, false);
    }
    const float* gm = p.in[7];
    f32x4 gv[4];
#pragma unroll
    for (int j = 0; j < 4; ++j) gv[j] = *((const f32x4*)gm + lane + 64 * j);
    bf16_t* XN = (bf16_t*)(ws + WS_XN);
    for (int m = gw; m < MT; m += NGW) {
        unsigned long long* o8 = (unsigned long long*)(XN + (size_t)m * DM) + lane;
        if (m >= MR) {
#pragma unroll
            for (int j = 0; j < 4; ++j) o8[64 * j] = 0ull;
            continue; }
        const f32x4* xr = (const f32x4*)(m < MP ? p.in[0] + (size_t)m * DM : p.in[1] + (size_t)(m - MP) * DM) + lane;
        f32x4 v[4]; float s = 0.f;
#pragma unroll
        for (int j = 0; j < 4; ++j) { v[j] = xr[64 * j]; s += (v[j].x * v[j].x + v[j].y * v[j].y) + (v[j].z * v[j].z + v[j].w * v[j].w); }
        const float rstd = 1.0f / sqrtf(wave_sum(s) * (1.f / DM) + RMS_EPS);
#pragma unroll
        for (int j = 0; j < 4; ++j) { const f32x4 y = v[j] * rstd * gv[j]; o8[64 * j] = (unsigned long long)pk2(y.x, y.y) | ((unsigned long long)pk2(y.z, y.w) << 32); }
    }
    const int gt = gw * 64 + lane;
    if (gt < NG * 64) {
        const int g = gt >> 6, pp = gt & 63;
        const double lr = (double)p.in[9][gt], li = (double)p.in[10][gt];
        const double dt = (double)expf(p.in[11][g]);
        double sn, cs; sincos_d(li * dt, sn, cs);
        const double er = exp_small_d(lr * dt);
        const double ar = er * cs, ai = er * sn;
        const double den = lr * lr + li * li;
        const double cr = ((ar - 1.0) * lr + ai * li) / den, ci = (ai * lr - (ar - 1.0) * li) / den;
        float* LAMB = (float*)(ws + WS_LAMB); LAMB[gt * 2] = (float)ar; LAMB[gt * 2 + 1] = (float)ai;
        bf16_t* BB = (bf16_t*)(ws + WS_BBAR); bf16_t* CM = (bf16_t*)(ws + WS_CMAT);
        for (int h = 0; h < 16; ++h) {
            const double br = (double)p.in[12][(size_t)gt * 16 + h], bi = (double)p.in[13][(size_t)gt * 16 + h];
            BB[((size_t)(g * 2 + 0) * 64 + pp) * 16 + h] = (bf16_t)f2bf((float)(cr * br - ci * bi));
            BB[((size_t)(g * 2 + 1) * 64 + pp) * 16 + h] = (bf16_t)f2bf((float)(cr * bi + ci * br));
            CM[((size_t)g * 16 + h) * 128 + 2 * pp] = (bf16_t)f2bf(p.in[14][((size_t)g * 16 + h) * 64 + pp]);
            CM[((size_t)g * 16 + h) * 128 + 2 * pp + 1] = (bf16_t)f2bf(-p.in[15][((size_t)g * 16 + h) * 64 + pp]);
        }
    }
}

constexpr int SW_ROW = 336, SW_BYTES = 2 * 16 * SW_ROW;
constexpr int LDS_BT = 8 * SW_BYTES;
struct S5Ctx { bf16x8 Bf[2][2], Cf[5]; float lrb[2], lib[2]; };
__device__ __forceinline__ void s5_setup(const P& p, S5Ctx& c, int g, int lane) {
    unsigned char* ws = p.ws; const int col = lane & 31, hi = lane >> 5;
    const bf16_t* BB = (const bf16_t*)(ws + WS_BBAR); const bf16_t* CM = (const bf16_t*)(ws + WS_CMAT); const float* LAMB = (const float*)(ws + WS_LAMB);
#pragma unroll
    for (int cc = 0; cc < 2; ++cc)
#pragma unroll
        for (int pt = 0; pt < 2; ++pt) c.Bf[cc][pt] = *(const bf16x8*)(BB + ((size_t)(g * 2 + cc) * 64 + 32 * pt + col) * 16 + 8 * hi);
#pragma unroll
    for (int ks = 0; ks < 4; ++ks) c.Cf[ks] = *(const bf16x8*)(CM + ((size_t)g * 16 + (lane & 15)) * 128 + 32 * ks + 8 * (lane >> 4));
    {
        const short dbf = (short)f2bf(p.in[16][g * 16 + (lane & 15)]); const int kq = lane >> 4, hh = lane & 15;
#pragma unroll
        for (int j = 0; j < 8; ++j) c.Cf[4][j] = (kq < 2 && 8 * kq + j == hh) ? dbf : (short)0;
    }
#pragma unroll
    for (int pt = 0; pt < 2; ++pt) { const int pp = 32 * pt + col; c.lrb[pt] = LAMB[(g * 64 + pp) * 2]; c.lib[pt] = LAMB[(g * 64 + pp) * 2 + 1]; }
}
template <bool DO_Y> __device__ __forceinline__ void s5_scan(const P& p, const S5Ctx& c, LAS unsigned char* sw, int g, size_t rb0, size_t rb1, int nit, float (&sr)[2], float (&si)[2], int lane) {
    const bf16_t* U = (const bf16_t*)(p.ws + WS_U); bf16_t* YS = (bf16_t*)(p.ws + WS_YS);
    const int col = lane & 31, hi = lane >> 5;
    if (DO_Y) { if (lane < 32) { *(LAS u32x4*)(sw + lane * SW_ROW + 288) = (u32x4){0u, 0u, 0u, 0u}; *(LAS u32x4*)(sw + lane * SW_ROW + 304) = (u32x4){0u, 0u, 0u, 0u}; } }
    const int rho = lane & 31; const int sA = (rho >> 2) & 1, tl = (rho & 3) + 4 * (rho >> 3);
    const bf16_t* ua_p = U + ((size_t)g * MT + (sA ? rb1 : rb0) + tl) * 16 + 8 * hi;
    LAS unsigned char* uw = sw + (sA * 16 + tl) * SW_ROW + 256 + 16 * hi;
    const f32x16 z16 = {0.f, 0.f, 0.f, 0.f, 0.f, 0.f, 0.f, 0.f, 0.f, 0.f, 0.f, 0.f, 0.f, 0.f, 0.f, 0.f};
    constexpr int PF = 4;
    bf16x8 ub[PF];
#pragma unroll
    for (int k = 0; k < PF; ++k) ub[k] = *(const bf16x8*)(ua_p + (size_t)(k < nit ? k : 0) * 16 * 16);
    for (int it0 = 0; it0 < nit; it0 += PF) {
#pragma unroll
        for (int k = 0; k < PF; ++k) {
            const int it = it0 + k;
            if (it < nit) {
                const bf16x8 ua = ub[k];
                { const int nx = it + PF; ub[k] = *(const bf16x8*)(ua_p + (size_t)(nx < nit ? nx : it) * 16 * 16); }
                if (DO_Y) *(LAS bf16x8*)uw = ua;
                f32x16 are[2], aim[2];
#pragma unroll
                for (int pt = 0; pt < 2; ++pt) { are[pt] = __builtin_amdgcn_mfma_f32_32x32x16_bf16(ua, c.Bf[0][pt], z16, 0, 0, 0); aim[pt] = __builtin_amdgcn_mfma_f32_32x32x16_bf16(ua, c.Bf[1][pt], z16, 0, 0, 0); }
                asm volatile("s_nop 15\n\ts_nop 15\n\ts_nop 15\n\ts_nop 15" ::: "memory");
#pragma unroll
                for (int r = 0; r < 16; ++r)
#pragma unroll
                    for (int pt = 0; pt < 2; ++pt) {
                        const float nr = __builtin_fmaf(c.lrb[pt], sr[pt], __builtin_fmaf(-c.lib[pt], si[pt], are[pt][r]));
                        const float ni = __builtin_fmaf(c.lrb[pt], si[pt], __builtin_fmaf(c.lib[pt], sr[pt], aim[pt][r]));
                        sr[pt] = nr; si[pt] = ni;
                        if (DO_Y) *(LAS unsigned*)(sw + (hi * 16 + r) * SW_ROW + (32 * pt + col) * 4) = cvt_pk_bf16(nr, ni);
                    }
                if (DO_Y) {
                    const int t0 = it * 16;
#pragma unroll
                    for (int s = 0; s < 2; ++s) {
                        f32x4 y = {0.f, 0.f, 0.f, 0.f};
                        bf16x8 af[5];
#pragma unroll
                        for (int ks = 0; ks < 5; ++ks) af[ks] = *(const LAS bf16x8*)(sw + (s * 16 + (lane & 15)) * SW_ROW + (32 * ks + 8 * (lane >> 4)) * 2);
                        asm volatile("s_waitcnt lgkmcnt(0)\n\ts_nop 7" ::: "memory");
#pragma unroll
                        for (int ks = 0; ks < 5; ++ks) y = __builtin_amdgcn_mfma_f32_16x16x32_bf16(af[ks], c.Cf[ks], y, 0, 0, 0);
                        asm volatile("s_nop 15\n\ts_nop 15" ::: "memory");
                        const size_t rb = (s ? rb1 : rb0) + t0 + 4 * (lane >> 4);
                        u32x2 w; w.x = cvt_pk_bf16(gelu_t(y[0]), gelu_t(y[1])); w.y = cvt_pk_bf16(gelu_t(y[2]), gelu_t(y[3]));
                        bf16_t* yo = YS + rb * 512 + 16 * g + (lane & 15);
                        yo[0] = (bf16_t)(w.x & 0xffff); yo[512] = (bf16_t)(w.x >> 16); yo[1024] = (bf16_t)(w.y & 0xffff); yo[1536] = (bf16_t)(w.y >> 16);
                    }
                }
            }
        }
    }
}
__device__ __forceinline__ void s5_sample_task(const P& p, LAS unsigned char* sw, int t2, int lane) {
    const int g = t2 & 31, n0 = 2 * (t2 >> 5), col = lane & 31, hi = lane >> 5;
    S5Ctx c; s5_setup(p, c, g, lane);
    float sr[2], si[2];
#pragma unroll
    for (int pt = 0; pt < 2; ++pt) { const size_t o = ((size_t)(n0 + hi) * 32 + g) * 64 + 32 * pt + col; sr[pt] = p.in[2][o]; si[pt] = p.in[3][o]; }
    const size_t rb0 = (size_t)MP + n0 * STT;
    s5_scan<true>(p, c, sw, g, rb0, rb0 + STT, 1, sr, si, lane);
#pragma unroll
    for (int pt = 0; pt < 2; ++pt) { const size_t o = ((size_t)(n0 + hi) * 32 + g) * 64 + 32 * pt + col; p.out[O_SRES + o] = sr[pt]; p.out[O_SIMS + o] = si[pt]; }
}
__device__ __forceinline__ void s5_prefix_task(const P& p, LAS unsigned char* sw, int bt, int seg, int lane) {
    const int g = bt & 31, n0 = 2 * (bt >> 5), col = lane & 31, hi = lane >> 5;
    S5Ctx c; s5_setup(p, c, g, lane);
    const size_t b0 = (size_t)n0 * SEQ;
    float sr[2] = {0.f, 0.f}, si[2] = {0.f, 0.f};
    s5_scan<false>(p, c, sw, g, b0, b0 + SEQ, 16 * seg, sr, si, lane);
    s5_scan<true>(p, c, sw, g, b0 + 256 * seg, b0 + SEQ + 256 * seg, 16, sr, si, lane);
    if (seg == 7) {
#pragma unroll
        for (int pt = 0; pt < 2; ++pt) { const size_t o = ((size_t)(n0 + hi) * 32 + g) * 64 + 32 * pt + col; p.out[O_SREP + o] = sr[pt]; p.out[O_SIMP + o] = si[pt]; }
    }
}
__device__ __forceinline__ void attn_task(const P& p, const LAS float* btab, int n, int c, int h, int lane) {
    unsigned char* ws = p.ws;
    const bf16_t* Q = (const bf16_t*)(ws + WS_Q); const bf16_t* KB = (const bf16_t*)(ws + WS_KB); const bf16_t* VT = (const bf16_t*)(ws + WS_VT); bf16_t* ATT = (bf16_t*)(ws + WS_ATT);
    const int q = lane & 31, hi = lane >> 5;
    const size_t rowq = (size_t)n * SEQ + 64 * c;
    bf16x8 qf[2][4];
#pragma unroll
    for (int qt = 0; qt < 2; ++qt)
#pragma unroll
        for (int ks = 0; ks < 4; ++ks) qf[qt][ks] = *(const bf16x8*)(Q + (rowq + 32 * qt + q) * 512 + 64 * h + 16 * ks + 8 * hi);
    f32x16 o[2][2];
#pragma unroll
    for (int a = 0; a < 2; ++a)
#pragma unroll
        for (int b = 0; b < 2; ++b)
#pragma unroll
            for (int r = 0; r < 16; ++r) o[a][b][r] = 0.f;
    float mrun[2] = {-1e30f, -1e30f}, lrun[2] = {0.f, 0.f};
    const int kstart = (c >= 8) ? 64 * (c - 8) : 0, kend = 64 * (c + 1);
    const bf16_t* kp = KB + (size_t)(n * 8 + h) * 64 * 2048 + hi * 256 + q * 8;
    const bf16_t* vp = VT + (size_t)(n * 8 + h) * 64 * 2048 + hi * 256 + q * 8;
    const LAS float* bt = btab + h * 257;
    bf16x8 kfn[4], vfn[2][2], kfm[4];
#pragma unroll
    for (int ks = 0; ks < 4; ++ks) { kfn[ks] = *(const bf16x8*)(kp + (size_t)(kstart >> 5) * 2048 + 512 * ks); kfm[ks] = *(const bf16x8*)(kp + (size_t)((kstart + 32) >> 5) * 2048 + 512 * ks); }
#pragma unroll
    for (int dt = 0; dt < 2; ++dt)
#pragma unroll
        for (int s = 0; s < 2; ++s) vfn[dt][s] = *(const bf16x8*)(vp + (size_t)(kstart >> 5) * 2048 + (dt * 2 + s) * 512);
    for (int kt = kstart; kt < kend; kt += 32) {
        bf16x8 kf[4], vf[2][2];
#pragma unroll
        for (int ks = 0; ks < 4; ++ks) { kf[ks] = kfn[ks]; kfn[ks] = kfm[ks]; }
#pragma unroll
        for (int dt = 0; dt < 2; ++dt)
#pragma unroll
            for (int s = 0; s < 2; ++s) vf[dt][s] = vfn[dt][s];
        { const int kn = (kt + 64 < kend) ? kt + 64 : kt, vn = (kt + 32 < kend) ? kt + 32 : kt;
#pragma unroll
        for (int ks = 0; ks < 4; ++ks) kfm[ks] = *(const bf16x8*)(kp + (size_t)(kn >> 5) * 2048 + 512 * ks);
#pragma unroll
        for (int dt = 0; dt < 2; ++dt)
#pragma unroll
            for (int s = 0; s < 2; ++s) vfn[dt][s] = *(const bf16x8*)(vp + (size_t)(vn >> 5) * 2048 + (dt * 2 + s) * 512); }
#pragma unroll
        for (int qt = 0; qt < 2; ++qt) {
            f32x16 st;
#pragma unroll
            for (int r = 0; r < 16; ++r) st[r] = 0.f;
            __builtin_amdgcn_s_setprio(1);
#pragma unroll
            for (int ks = 0; ks < 4; ++ks) st = __builtin_amdgcn_mfma_f32_32x32x16_bf16(kf[ks], qf[qt][ks], st, 0, 0, 0);
            __builtin_amdgcn_s_setprio(0);
            const int relmin = 64 * c + 32 * qt - kt - 31;
            if (relmin < 128) {
                const int relb = 64 * c + 32 * qt + q - kt;
#pragma unroll
                for (int r = 0; r < 16; ++r) { const int kl = (r & 3) + 4 * ((r >> 2) & 1) + 8 * hi + 16 * (r >> 3); int rel = relb - kl; rel = rel < -128 ? -128 : (rel > 128 ? 128 : rel); st[r] += bt[rel + 128]; }
            }
            float mx = st[0];
#pragma unroll
            for (int r = 1; r < 16; ++r) mx = fmaxf(mx, st[r]);
            mx = fmaxf(mx, __shfl_xor(mx, 32));
            const bool grow = mx > mrun[qt] + 8.0f;
            const float mnew = grow ? mx : mrun[qt];
            if (__builtin_amdgcn_ballot_w64(grow) != 0ull) {
                const float alpha = ex2(mrun[qt] - mnew);
                lrun[qt] *= alpha;
#pragma unroll
                for (int dt = 0; dt < 2; ++dt)
#pragma unroll
                    for (int r = 0; r < 16; ++r) o[dt][qt][r] *= alpha;
            }
            mrun[qt] = mnew;
            float ps = 0.f;
#pragma unroll
            for (int r = 0; r < 16; ++r) { st[r] = ex2(st[r] - mnew); ps += st[r]; }
            ps += __shfl_xor(ps, 32); lrun[qt] += ps;
            bf16x8 pf[2];
#pragma unroll
            for (int s = 0; s < 2; ++s) { u32x4 w; w.x = cvt_pk_bf16(st[8 * s], st[8 * s + 1]); w.y = cvt_pk_bf16(st[8 * s + 2], st[8 * s + 3]); w.z = cvt_pk_bf16(st[8 * s + 4], st[8 * s + 5]); w.w = cvt_pk_bf16(st[8 * s + 6], st[8 * s + 7]); pf[s] = __builtin_bit_cast(bf16x8, w); }
            __builtin_amdgcn_s_setprio(1);
#pragma unroll
            for (int dt = 0; dt < 2; ++dt)
#pragma unroll
                for (int s = 0; s < 2; ++s) o[dt][qt] = __builtin_amdgcn_mfma_f32_32x32x16_bf16(vf[dt][s], pf[s], o[dt][qt], 0, 0, 0);
            __builtin_amdgcn_s_setprio(0);
        }
    }
#pragma unroll
    for (int qt = 0; qt < 2; ++qt) {
        const float inv = 1.0f / lrun[qt];
        bf16_t* op = ATT + (rowq + 32 * qt + q) * 512 + 64 * h + 4 * hi;
#pragma unroll
        for (int dt = 0; dt < 2; ++dt)
#pragma unroll
            for (int rg = 0; rg < 4; ++rg) { u32x2 w; w.x = cvt_pk_bf16(o[dt][qt][4 * rg] * inv, o[dt][qt][4 * rg + 1] * inv); w.y = cvt_pk_bf16(o[dt][qt][4 * rg + 2] * inv, o[dt][qt][4 * rg + 3] * inv);
                *(u32x2*)(op + 32 * dt + 8 * rg) = w; }
    }
}

__device__ __forceinline__ void attn_sample_task(const P& p, const LAS float* btab, LAS float* pl, int task, int lane) {
    const int t = task & 15, h = (task >> 4) & 7, n = task >> 7;
    const bf16_t* Q = (const bf16_t*)(p.ws + WS_Q); bf16_t* ATT = (bf16_t*)(p.ws + WS_ATT);
    const size_t row = (size_t)MP + n * STT + t;
    const bf16_t* qp = Q + row * 512 + 64 * h;
    const float* ck = p.in[4]; const float* cv = p.in[5]; const float* nk = p.out + O_KS; const float* nv = p.out + O_VS;
    const LAS float* bt = btab + h * 257;
    const int kq_ = lane >> 4, d4_ = (lane & 15) * 4;
    const u32x2 qw = *(const u32x2*)(qp + d4_);
    const float q0 = bflo(qw.x), q1 = bfhi(qw.x), q2 = bflo(qw.y), q3 = bfhi(qw.y);
#pragma unroll 1
    for (int s0 = 0; s0 < 132; s0 += 22) {
        f32x4 kk[22];
#pragma unroll
        for (int s = 0; s < 22; ++s) { const int j = 4 * (s0 + s) + kq_;
            const float* kr = (j < 512) ? ck + (((size_t)n * 512 + j) * 8 + h) * 64 : nk + (((size_t)n * 16 + (j - 512)) * 8 + h) * 64; kk[s] = *(const f32x4*)(kr + d4_); }
#pragma unroll
        for (int s = 0; s < 22; ++s) {
            float part = (q0 * kk[s][0] + q1 * kk[s][1]) + (q2 * kk[s][2] + q3 * kk[s][3]);
            part += __shfl_xor(part, 1); part += __shfl_xor(part, 2); part += __shfl_xor(part, 4); part += __shfl_xor(part, 8);
            if ((lane & 15) == 0) { const int j = 4 * (s0 + s) + kq_; int rel = t + 512 - j; rel = rel > 128 ? 128 : (rel < -128 ? -128 : rel); pl[j] = part + bt[rel + 128]; }
        }
    }
    asm volatile("s_waitcnt lgkmcnt(0)" ::: "memory");
    float sc[9]; float mx = -1e30f;
#pragma unroll
    for (int i = 0; i < 9; ++i) { const int j = lane + 64 * i; sc[i] = (j < 528) ? pl[j] : -1e30f; mx = fmaxf(mx, sc[i]); }
#pragma unroll
    for (int o = 1; o < 64; o <<= 1) mx = fmaxf(mx, __shfl_xor(mx, o));
    float sum = 0.f;
#pragma unroll
    for (int i = 0; i < 9; ++i) { sc[i] = ex2(sc[i] - mx); sum += sc[i]; }
    sum = wave_sum(sum);
    f32x4 acc = {0.f, 0.f, 0.f, 0.f};
    const int kq = lane >> 4, d4 = (lane & 15) * 4;
#pragma unroll
    for (int i = 0; i < 9; ++i) if (i < 8 || lane < 16) pl[lane + 64 * i] = sc[i];
    asm volatile("s_waitcnt lgkmcnt(0)" ::: "memory");
#pragma unroll 1
    for (int s0 = 0; s0 < 132; s0 += 22) {
        f32x4 vv[22];
#pragma unroll
        for (int s = 0; s < 22; ++s) { const int j = 4 * (s0 + s) + kq;
            const float* vr = (j < 512) ? cv + (((size_t)n * 512 + j) * 8 + h) * 64 : nv + (((size_t)n * 16 + (j - 512)) * 8 + h) * 64; vv[s] = *(const f32x4*)(vr + d4); }
#pragma unroll
        for (int s = 0; s < 22; ++s) { const float pj = pl[4 * (s0 + s) + kq]; acc += vv[s] * pj; }
    }
#pragma unroll
    for (int e = 0; e < 4; ++e) { acc[e] += __shfl_xor(acc[e], 16); acc[e] += __shfl_xor(acc[e], 32); }
    if (kq == 0) { const float inv = 1.0f / sum; u32x2 w; w.x = cvt_pk_bf16(acc[0] * inv, acc[1] * inv); w.y = cvt_pk_bf16(acc[2] * inv, acc[3] * inv); *(u32x2*)(ATT + row * 512 + 64 * h + d4) = w; }
}
#define RLX_AGENT __ATOMIC_RELAXED, __HIP_MEMORY_SCOPE_AGENT
#define XB_TMO      128
#define XB_XCNT(j)  (256  + 64 * (j))
#define XB_XSUB(j)  (1280 + 64 * (j))
#define XB_XGEN(j)  (2304 + 64 * (j))
#define XB_TOP      3328
#define XB_TOPGEN   3392
#define XCD_BAR_WORDS 3456
#define XB_SPIN_CAP (1u << 18)

__device__ __forceinline__ unsigned xb_ld(unsigned* p)              { return __hip_atomic_load(p, __ATOMIC_RELAXED, __HIP_MEMORY_SCOPE_AGENT); }
__device__ __forceinline__ unsigned xb_add(unsigned* p, unsigned v) { return __hip_atomic_fetch_add(p, v, __ATOMIC_RELAXED, __HIP_MEMORY_SCOPE_AGENT); }
__device__ __forceinline__ unsigned xb_xcc_id() { return (unsigned)__builtin_amdgcn_s_getreg((3 << 11) | 20) & 0xFu; }
#define XB_SPIN(cond, bar) do { unsigned _sp = 0; while (cond) { __builtin_amdgcn_s_sleep(1); \
    if ((++_sp & 255u) == 0u) { if (xb_ld(&(bar)[XB_TMO])) break; if (_sp > XB_SPIN_CAP) { atomicAdd(&(bar)[XB_TMO], 1u); break; } } } } while (0)

struct XcdBarrier {
    unsigned* bar; unsigned x;
    volatile LAS unsigned* st;
};

__device__ __forceinline__ XcdBarrier xcd_barrier_post(unsigned* bar, volatile LAS unsigned* st) {
    XcdBarrier b; b.bar = bar; b.x = xb_xcc_id(); b.st = st;
    if (threadIdx.x == 0) (void)xb_add(&bar[XB_XCNT(b.x)], 1u);
    return b;
}
__device__ __forceinline__ void xcd_barrier_complete(unsigned* bar, unsigned x, unsigned& nloc, unsigned& nx) {
    const unsigned G = gridDim.x * gridDim.y * gridDim.z;
    unsigned sum, cnt, mine, sp = 0u;
    for (;;) {
        sum = 0u; cnt = 0u; mine = 0u;
#pragma unroll
        for (unsigned j = 0; j < 16; ++j) { const unsigned c = xb_ld(&bar[XB_XCNT(j)]); sum += c; cnt += (c > 0u) ? 1u : 0u; mine = (j == x) ? c : mine; }
        if (sum == G) break;
        __builtin_amdgcn_s_sleep(1);
        if ((++sp & 255u) == 0u) { if (xb_ld(&bar[XB_TMO])) break; if (sp > XB_SPIN_CAP) { atomicAdd(&bar[XB_TMO], 1u); break; } }
    }
    nloc = mine > 0u ? mine : 1u; nx = cnt > 0u ? cnt : 1u;
}

__device__ __forceinline__ void xcd_barrier(const XcdBarrier& b) {
    asm volatile("s_waitcnt vmcnt(0)" ::: "memory");
    __syncthreads();
    if (threadIdx.x == 0) {
        unsigned* bar = b.bar;
        __builtin_amdgcn_s_waitcnt(0);
        unsigned nloc = b.st[0], nx = b.st[1];
        if (nloc == 0u) { xcd_barrier_complete(bar, b.x, nloc, nx); b.st[0] = nloc; b.st[1] = nx; }
        const unsigned old = xb_add(&bar[XB_XSUB(b.x)], 1u);
        const unsigned gen = old / nloc;
        if (old + 1u == (gen + 1u) * nloc) {
            __builtin_amdgcn_fence(__ATOMIC_RELEASE, "agent");
            asm volatile("s_waitcnt vmcnt(0)" ::: "memory");
            const unsigned og = xb_add(&bar[XB_TOP], 1u);
            const unsigned tg = og / nx;
            if (og + 1u == (tg + 1u) * nx) xb_add(&bar[XB_TOPGEN], 1u);
            else XB_SPIN(xb_ld(&bar[XB_TOPGEN]) == tg, bar);
            __builtin_amdgcn_fence(__ATOMIC_ACQUIRE, "agent");
            xb_add(&bar[XB_XGEN(b.x)], 1u);
            asm volatile("s_waitcnt vmcnt(0)" ::: "memory");
        } else {
            XB_SPIN(xb_ld(&bar[XB_XGEN(b.x)]) == gen, bar);
            __builtin_amdgcn_fence(__ATOMIC_ACQUIRE, "agent");
            asm volatile("s_waitcnt vmcnt(0)" ::: "memory");
        }
    }
    __syncthreads();
}

struct Args { P p; int ph_lo, ph_hi; };
constexpr int NPH = 10;
__global__ void __launch_bounds__(512, 2) mk_fwd(Args args) {
    extern __shared__ __attribute__((aligned(16))) unsigned char lds_raw[];
    LAS unsigned char* lds = (LAS unsigned char*)lds_raw;
    const P& p = args.p;
    const int tid = threadIdx.x, lane = tid & 63, wave = __builtin_amdgcn_readfirstlane(tid >> 6);
    const int G = gridDim.x, bx = blockIdx.x;
    const int vb = (G % 8 == 0) ? (bx % 8) * (G / 8) + bx / 8 : bx;
    unsigned char* ws = p.ws;
    const int lo = args.ph_lo, hi = args.ph_hi;
#define IN(k) (lo <= (k) && (k) < hi)
    volatile LAS unsigned* bst = (volatile LAS unsigned*)(lds + 131072 + 64);
    if (tid < 2) bst[tid] = 0u;
    __syncthreads();
    XcdBarrier bar; bar.bar = (unsigned*)(ws + CTL_BAR); bar.x = 0; bar.st = nullptr;
    if (hi - lo > 1) bar = xcd_barrier_post((unsigned*)(ws + CTL_BAR), bst);
#define SEAM(k) do { if (IN(k) && IN((k) + 1)) { xcd_barrier(bar); } } while (0)
    bf16_t* XN = (bf16_t*)(ws + WS_XN);
    float* ssq2 = (float*)(ws + CTL_SSQ2); float* ssq3 = (float*)(ws + CTL_SSQ3);

    if (hi > NPH) cg::this_grid().sync();
    if (IN(0)) { p0_prologue(p, lds, vb, G, wave, lane); }
    SEAM(0);
    if (IN(1)) {
        pg8::Gemm g{XN, (const bf16_t*)(ws + WS_WIN), MT, DIN, 1024, 1024}; pg8::StaticOrder S; S.init(MP, DIN, G, bx); pg8::PanelOrder S2; S2.init(NPAN - 1, DIN, G, (bx + 128) % G);
        EpiIn E{(bf16_t*)(ws + WS_U), (bf16_t*)(ws + WS_Q), (bf16_t*)(ws + WS_KB), (bf16_t*)(ws + WS_VT), (bf16_t*)(ws + WS_SG), (bf16_t*)(ws + WS_SA), p.out};
        pg8::gemm_phase<EpiIn, pg8::StaticOrder, true, true>(lds, g, S, E);
        pg8::gemm_phase<EpiIn, pg8::PanelOrder, true, true, true>(lds, g, S2, E);
    }
    SEAM(1);
    if (IN(2)) {
        LAS float* btab = (LAS float*)(lds + LDS_BT);
        for (int i = tid; i < 8 * 257; i += 512) btab[i] = (p.in[18][i] - p.in[18][(i / 257) * 257 + 256]) * LOG2E;
        __syncthreads();
        unsigned* qctr = (unsigned*)(ws + WS_CTL);
        constexpr int T_S5P = 256, T_S5S = 128, T_ATT = NB * 32 * 8, T_ATS = SBT * 8 * STT;
        constexpr int T_TOTAL = T_S5P + T_S5S + T_ATT + T_ATS;
        for (int bt = bx; bt < T_S5P; bt += G) { int ln = lane; asm volatile("" : "+v"(ln)); s5_prefix_task(p, lds + wave * SW_BYTES, bt, 7 - wave, ln); }
        for (;;) {
            int task = 0;
            if (lane == 0) task = (int)atomicAdd(qctr, 1u) + T_S5P;
            task = __builtin_amdgcn_readfirstlane(task);
            if (task >= T_TOTAL) break;
            int ln = lane; asm volatile("" : "+v"(ln));
            if (task < T_S5P + T_ATS) attn_sample_task(p, btab, (LAS float*)(lds + wave * SW_BYTES), task - T_S5P, ln);
            else if (task < T_S5P + T_ATS + T_S5S) s5_sample_task(p, lds + wave * SW_BYTES, task - (T_S5P + T_ATS), ln);
            else { const int a = task - (T_S5P + T_ATS + T_S5S); attn_task(p, btab, a >> 8, (a >> 3) & 31, a & 7, ln); }
        }
        __syncthreads();
    }
    SEAM(2);
    if (IN(3)) {
        pg8::Gemm g{(const bf16_t*)(ws + WS_ATT), (const bf16_t*)(ws + WS_WAU), MT, 1024, 512, 512}; pg8::StaticOrder S; S.init(MP, 1024, G, bx); pg8::PanelOrder S2; S2.init(NPAN - 1, 1024, G, (bx + 128) % G);
        EpiAttUp E{(const bf16_t*)(ws + WS_SA), XN};
        pg8::gemm_phase<EpiAttUp, pg8::StaticOrder, true, true>(lds, g, S, E);
        pg8::gemm_phase<EpiAttUp, pg8::PanelOrder, true, true, true>(lds, g, S2, E);
    }
    SEAM(3);
    if (IN(4)) {
        pg8::Gemm g{(const bf16_t*)(ws + WS_YS), (const bf16_t*)(ws + WS_WGLU), MT, 2048, 512, 512}; pg8::StaticOrder S; S.init(MP, 2048, G, bx); pg8::PanelOrder S2; S2.init(NPAN - 1, 2048, G, (bx + 128) % G);
        EpiGlu E{(const bf16_t*)(ws + WS_SG), XN};
        pg8::gemm_phase<EpiGlu, pg8::StaticOrder, true, true>(lds, g, S, E);
        pg8::gemm_phase<EpiGlu, pg8::PanelOrder, true, true, true>(lds, g, S2, E);
    }
    SEAM(4);
    if (IN(5)) {
        pg8::Gemm g{XN, (const bf16_t*)(ws + WS_WO), MT, 1024, 1024, 1024}; pg8::StaticOrder S; S.init(MP, 1024, G, bx); pg8::PanelOrder S2; S2.init(NPAN - 1, 1024, G, (bx + 128) % G);
        EpiRes<true> E{p.in[0], p.in[1], p.out, (bf16_t*)(ws + WS_HB), ssq2};
        pg8::gemm_phase<EpiRes<true>, pg8::StaticOrder, true, true>(lds, g, S, E);
        pg8::gemm_phase<EpiRes<true>, pg8::PanelOrder, true, true, true>(lds, g, S2, E);
    }
    SEAM(5);
    if (IN(6)) {
        pg8::Gemm g{(const bf16_t*)(ws + WS_HB), (const bf16_t*)(ws + WS_WUP), MT, 2 * DFF, 1024, 1024}; pg8::StaticOrder S; S.init(MP, 2 * DFF, G, bx); pg8::PanelOrder S2; S2.init(NPAN - 1, 2 * DFF, G, (bx + 128) % G);
        EpiUp E{(bf16_t*)(ws + WS_G), (float*)(ws + WS_HALO), (float*)(ws + WS_SIDEA), (float*)(ws + WS_SIDEB), ssq2, p.in[23], p.in[24], p.in[6], p.out};
        pg8::gemm_phase<EpiUp, pg8::StaticOrder, true, true>(lds, g, S, E);
        pg8::gemm_phase<EpiUp, pg8::PanelOrder, true, true, true>(lds, g, S2, E);
    }
    SEAM(6);
    if (IN(7)) {
        const float* HALO = (const float*)(ws + WS_HALO); const float* SA_ = (const float*)(ws + WS_SIDEA); const float* SB_ = (const float*)(ws + WS_SIDEB);
        bf16_t* Gp = (bf16_t*)(ws + WS_G); const float* taps = p.in[23]; const float* cbv = p.in[24];
        const int nthr = G * 512, gtid = vb * 512 + tid;
        constexpr int CQ = DFF / 4;
        for (int idx = gtid; idx < 512 * 2 * CQ; idx += nthr) {
            const int c = (idx % CQ) * 4, bi = idx / CQ, i = bi & 1, blk = bi >> 1;
            const f32x4 ac = *(const f32x4*)(SA_ + ((size_t)blk * 2 + i) * DFF + c), bv = *(const f32x4*)(SB_ + ((size_t)blk * 2 + i) * DFF + c);
            f32x4 a1 = {0.f, 0.f, 0.f, 0.f}, a2 = {0.f, 0.f, 0.f, 0.f};
            const bool first = (blk & 31) == 0;
            if (i == 1) { a1 = *(const f32x4*)(SA_ + ((size_t)blk * 2) * DFF + c); if (!first) a2 = *(const f32x4*)(HALO + ((size_t)(blk - 1) * 2 + 1) * DFF + c); }
            else if (!first) { a1 = *(const f32x4*)(HALO + ((size_t)(blk - 1) * 2 + 1) * DFF + c); a2 = *(const f32x4*)(HALO + ((size_t)(blk - 1) * 2) * DFF + c); }
            const f32x4 t0 = *(const f32x4*)(taps + c), t1 = *(const f32x4*)(taps + DFF + c), t2 = *(const f32x4*)(taps + 2 * DFF + c), cb = *(const f32x4*)(cbv + c);
            f32x4 g;
#pragma unroll
            for (int e = 0; e < 4; ++e) g[e] = gelu_t(cb[e] + t0[e] * a2[e] + t1[e] * a1[e] + t2[e] * ac[e]) * bv[e];
            u32x2 w; w.x = cvt_pk_bf16(g[0], g[1]); w.y = cvt_pk_bf16(g[2], g[3]);
            *(u32x2*)(Gp + ((size_t)blk * 64 + i) * DFF + c) = w;
        }
        for (int idx = gtid; idx < NB * 2 * CQ; idx += nthr) {
            const int c = (idx % CQ) * 4, bi = idx / CQ, j = bi & 1, nb = bi >> 1;
            *(f32x4*)(p.out + O_CP + ((size_t)nb * 2 + j) * DFF + c) = *(const f32x4*)(HALO + ((size_t)(nb * 32 + 31) * 2 + j) * DFF + c);
        }
    }
    SEAM(7);
    if (IN(8)) {
        pg8::Gemm g{(const bf16_t*)(ws + WS_G), (const bf16_t*)(ws + WS_WDN), MT, 1024, DFF, DFF}; pg8::StaticOrder S; S.init(MP, 1024, G, bx); pg8::PanelOrder S2; S2.init(NPAN - 1, 1024, G, (bx + 128) % G);
        EpiRes<false> E{nullptr, nullptr, p.out, nullptr, ssq3};
        pg8::gemm_phase<EpiRes<false>, pg8::StaticOrder, true, true>(lds, g, S, E);
        { pg8::Gemm gs{(const bf16_t*)(ws + WS_G), (const bf16_t*)(ws + WS_WDN), MT, 1024, 256, DFF}; pg8::PanelOrder S3; S3.init(NPAN - 1, 1024, G, (bx + 128) % G, DFF / 256);
          EpiAddSample E3{p.out};
          pg8::gemm_phase<EpiAddSample, pg8::PanelOrder, true, true, true>(lds, gs, S3, E3); }
    }
    SEAM(8);
    if (IN(9)) {
        const int gw = vb * 8 + wave, NGW = G * 8;
        f32x4 gv[4];
#pragma unroll
        for (int j = 0; j < 4; ++j) gv[j] = *((const f32x4*)p.in[26] + lane + 64 * j);
        for (int m = gw; m < MR; m += 2 * NGW) {
            const int m2 = m + NGW; const bool has2 = m2 < MR;
            f32x4* r = (f32x4*)hrow(p.out, m) + lane; f32x4* r2 = (f32x4*)hrow(p.out, has2 ? m2 : m) + lane;
            f32x4 v[4], w[4]; float s = 0.f, s2 = 0.f;
#pragma unroll
            for (int j = 0; j < 4; ++j) { v[j] = r[64 * j]; w[j] = r2[64 * j]; }
#pragma unroll
            for (int j = 0; j < 4; ++j) { s += (v[j].x * v[j].x + v[j].y * v[j].y) + (v[j].z * v[j].z + v[j].w * v[j].w); s2 += (w[j].x * w[j].x + w[j].y * w[j].y) + (w[j].z * w[j].z + w[j].w * w[j].w); }
            const float rs = 1.0f / sqrtf(wave_sum(s) * (1.0f / DM) + RMS_EPS), rs2 = 1.0f / sqrtf(wave_sum(s2) * (1.0f / DM) + RMS_EPS);
#pragma unroll
            for (int j = 0; j < 4; ++j) r[64 * j] = v[j] * rs * gv[j];
            if (has2) {
#pragma unroll
                for (int j = 0; j < 4; ++j) r2[64 * j] = w[j] * rs2 * gv[j]; }
        }
    }
#undef IN
#undef SEAM
}

extern "C" void kernel_launch(void* const* d_in, const int* in_sizes, int n_in, void* d_out, int out_size, void* d_ws, size_t ws_size, hipStream_t stream) {
    static int grid = 0;
    if (grid == 0) {
        if (n_in != 27 || in_sizes[0] != MP * DM || (size_t)out_size != O_END || ws_size < WS_END) {
            fprintf(stderr, "kernel_launch: unexpected shapes: n_in %d in0 %d out %d ws %zu (need %zu)\n", n_in, n_in > 0 ? in_sizes[0] : -1, out_size, ws_size, (size_t)WS_END); grid = -1; return; }
        int dev = 0, cus = 0, per_cu = 0;
        hipGetDevice(&dev); hipDeviceGetAttribute(&cus, hipDeviceAttributeMultiprocessorCount, dev);
        if (hipFuncSetAttribute((const void*)mk_fwd, hipFuncAttributeMaxDynamicSharedMemorySize, LDS_BYTES) != hipSuccess) { fprintf(stderr, "kernel_launch: hipFuncSetAttribute failed\n"); grid = -1; return; }
        if (hipOccupancyMaxActiveBlocksPerMultiprocessor(&per_cu, (const void*)mk_fwd, 512, LDS_BYTES) != hipSuccess || per_cu < 1) { fprintf(stderr, "kernel_launch: occupancy query says %d\n", per_cu); per_cu = 1; }
        (void)hipGetLastError();
        grid = cus;
    }
    if (grid < 0) return;
    hipMemsetAsync((char*)d_ws + WS_CTL, 0, CTL_BYTES, stream);
    Args a{};
    for (int i = 0; i < 27; ++i) a.p.in[i] = (const float*)d_in[i];
    a.p.out = (float*)d_out; a.p.ws = (unsigned char*)d_ws;
#if MK_N_LAUNCHES == 1
    a.ph_lo = 0; a.ph_hi = NPH;
    void* kargs[] = {&a};
    hipError_t e = hipLaunchCooperativeKernel((const void*)mk_fwd, dim3(grid), dim3(512), kargs, LDS_BYTES, stream);
    if (e != hipSuccess) fprintf(stderr, "kernel_launch: cooperative launch failed: %s (grid %d)\n", hipGetErrorString(e), grid);
#else
    for (int ph = 0; ph < NPH; ++ph) { a.ph_lo = ph; a.ph_hi = ph + 1; hipLaunchKernelGGL(mk_fwd, dim3(grid), dim3(512), LDS_BYTES, stream, a); }
#endif
}
```

```cpp
#include <hip/hip_runtime.h>
#include <hip/hip_cooperative_groups.h>
#include <cstdio>
#include <cstdint>
namespace cg = cooperative_groups;
namespace pg8 {
#define PG8_LAS __attribute__((address_space(3)))
typedef unsigned short bf16_t;
typedef short bf16x8 __attribute__((ext_vector_type(8)));
typedef float f32x4 __attribute__((ext_vector_type(4)));
typedef unsigned u32x4 __attribute__((ext_vector_type(4)));
constexpr int BM = 256, BK = 64, HALF = 128, HTB = HALF * BK * 2  , STAGE_BYTES = 8 * HTB, NXCD = 8, WGM = 4;

__host__ __device__ __forceinline__ int lds_byte(int r, int c) { const int st = (r >> 4) * 2 + (c >> 5), rr = r & 15, cc = c & 31, ob = rr * 64 + cc * 2; return st * 1024 + (ob ^ (((ob >> 9) & 1) << 5)); }
__host__ __device__ __forceinline__ void stage_rc(int b, int& R, int& C) { const int st = b / 1024, sb = b % 1024, swz = sb ^ (((sb >> 9) & 1) << 5); R = (st >> 1) * 16 + swz / 64; C = (st & 1) * 32 + (swz % 64) / 2; }
__host__ __device__ __forceinline__ int perm32(int rho) { const int n = rho >> 4, i = rho & 15; return 8 * (i >> 2) + 4 * n + (i & 3); }

struct Unit { int pm, pn, kc; };
struct Gemm { const bf16_t* A; const bf16_t* Bt; int M, N, K, ld; };

struct StaticOrder {
    int nM, nN, nwg, G, c;
    __host__ __device__ void init(int M, int N, int G_, int c_) { nM = M / BM; nN = N / BM; nwg = nM * nN; G = G_; c = c_; }
    __host__ __device__ bool next(int i, Unit& u) const {
        const long L = (long)i * G + c; if (L >= nwg) return false;
        int wgid = (int)L; { const int q = nwg / NXCD, r = nwg % NXCD, xcd = wgid % NXCD, off = wgid / NXCD; wgid = (xcd < r ? xcd * (q + 1) : r * (q + 1) + (xcd - r) * q) + off; }
        const int nig = WGM * nN, gid = wgid / nig, fm = gid * WGM, gsz = (nM - fm) < WGM ? (nM - fm) : WGM;
        u.pm = fm + ((wgid % nig) % gsz); u.pn = (wgid % nig) / gsz; u.kc = 0; return true;
    }
    __device__ __forceinline__ void a_ready(const Unit&) const {}
    __device__ __forceinline__ void done(const Unit&) const {}
};

struct PanelOrder {
    int nN, G, c, pm, nK;
    __host__ __device__ void init(int pm_, int N, int G_, int c_, int nK_ = 1) { nN = N / BM; G = G_; c = c_; pm = pm_; nK = nK_; }
    __host__ __device__ bool next(int i, Unit& u) const { const int L = i * G + c; if (L >= nN * nK) return false; u.pm = pm; u.pn = L % nN; u.kc = L / nN; return true; }
    __device__ __forceinline__ void a_ready(const Unit&) const {}
    __device__ __forceinline__ void done(const Unit&) const {}
};

typedef float f32x2_t __attribute__((ext_vector_type(2))); typedef __bf16 bf16x2_t __attribute__((ext_vector_type(2)));
__device__ __forceinline__ unsigned cvt_pk_bf16(float lo, float hi) { f32x2_t v = {lo, hi}; bf16x2_t b = __builtin_convertvector(v, bf16x2_t); return __builtin_bit_cast(unsigned, b); }
typedef float f32x2 __attribute__((ext_vector_type(2)));
template <class Epi, class Sched, bool ALIGN_EPI = false, bool SP2 = false, bool HALFM = false>
__device__ __forceinline__ void gemm_phase(PG8_LAS unsigned char* lds, const Gemm g, const Sched& S, const Epi& E) {
    const int tid = threadIdx.x, wid = __builtin_amdgcn_readfirstlane(tid >> 6), lane = tid & 63, wr = wid >> 2, wc = wid & 3, fr = lane & 15, fq = lane >> 4;
    const int K = g.ld, nt = g.K / BK;
    unsigned voffA[2], voffB[2];
#pragma unroll
    for (int i = 0; i < 2; ++i) { int R, C; stage_rc(tid * 16 + i * 8192, R, C); const int Rb = Epi::PERM ? ((R & ~31) + perm32(R & 31)) : R;
        voffA[i] = (unsigned)(R * K + C) * 2u; voffB[i] = (unsigned)(Rb * K + C) * 2u; }
    const size_t kstep = (size_t)(BK * 2);
    const size_t hstep = (size_t)HALF * K * 2;
    const size_t tstep = 2 * hstep;
    const unsigned ldsw = (unsigned)wid * 1024u;
    const int aoff = lds_byte(wr * 64 + fr, fq * 8), boff = lds_byte(wc * 32 + fr, fq * 8);
#define PG8_SA(b, h) (((b) * 2 + (h)) * HTB)
#define PG8_SB(b, h) ((4 + (b) * 2 + (h)) * HTB)
#define PG8_STAGE(bufoff, gbase, voff) do { _Pragma("unroll") for (int _i = 0; _i < 2; ++_i) \
        __builtin_amdgcn_global_load_lds((const unsigned*)((const char*)(gbase) + (voff)[_i]), (PG8_LAS unsigned*)(lds + (bufoff) + ldsw + _i * 8192), 16, 0, 0); } while (0)
#define PG8_LDA(dst, b, h) do { _Pragma("unroll") for (int m = 0; m < 4; ++m) _Pragma("unroll") for (int k = 0; k < 2; ++k) dst[m][k] = *(const PG8_LAS bf16x8*)(lds + PG8_SA(b, h) + aoff + m * 2048 + k * 1024); } while (0)
#define PG8_LDB(dst, b, h) do { _Pragma("unroll") for (int n = 0; n < 2; ++n) _Pragma("unroll") for (int k = 0; k < 2; ++k) dst[n][k] = *(const PG8_LAS bf16x8*)(lds + PG8_SB(b, h) + boff + n * 2048 + k * 1024); } while (0)
#define PG8_MMA(ai, bj, At, Bt) do { __builtin_amdgcn_s_setprio(1); _Pragma("unroll") for (int m = 0; m < 4; ++m) _Pragma("unroll") for (int n = 0; n < 2; ++n) _Pragma("unroll") for (int k = 0; k < 2; ++k) \
        acc[ai][bj][m][n] = __builtin_amdgcn_mfma_f32_16x16x32_bf16(Bt[n][k], At[m][k], acc[ai][bj][m][n], 0, 0, 0); __builtin_amdgcn_s_setprio(0); } while (0)
#define PG8_WAIT_V(n) asm volatile("s_waitcnt vmcnt(" #n ")" ::: "memory")
#define PG8_WAIT_L(n) asm volatile("s_waitcnt lgkmcnt(" #n ")" ::: "memory")
#define PG8_BAR __builtin_amdgcn_s_barrier()
#define PG8_SCHED __builtin_amdgcn_sched_barrier(0)
    Unit cur, nxt; int ui = 0;
    if (!S.next(0, cur)) return;
    f32x4 acc[2][2][4][2];
#pragma unroll
    for (int a = 0; a < 2; ++a)
#pragma unroll
        for (int b = 0; b < 2; ++b)
#pragma unroll
            for (int m = 0; m < 4; ++m)
#pragma unroll
                for (int n = 0; n < 2; ++n) acc[a][b][m][n] = (f32x4){0.f, 0.f, 0.f, 0.f};
    bf16x8 At[4][2], B0[2][2], B1[2][2];
    const char* cA = (const char*)g.A + (size_t)cur.pm * tstep + (size_t)cur.kc * g.K * 2; const char* cB = (const char*)g.Bt + (size_t)cur.pn * tstep + (size_t)cur.kc * g.K * 2;
    S.a_ready(cur);
    if constexpr (SP2) {
        PG8_STAGE(PG8_SB(0, 0), cB, voffB); PG8_STAGE(PG8_SB(0, 1), cB + hstep, voffB); PG8_STAGE(PG8_SA(0, 0), cA, voffA); PG8_STAGE(PG8_SA(0, 1), cA + hstep, voffA);
        if (wr == 1) PG8_BAR;
        PG8_WAIT_V(2); PG8_BAR;
        PG8_STAGE(PG8_SB(1, 0), cB + kstep, voffB); PG8_STAGE(PG8_SA(1, 0), cA + kstep, voffA); PG8_STAGE(PG8_SB(1, 1), cB + hstep + kstep, voffB);
        PG8_WAIT_V(6); PG8_BAR;
    } else {
        PG8_STAGE(PG8_SB(0, 0), cB, voffB); PG8_STAGE(PG8_SA(0, 0), cA, voffA); PG8_STAGE(PG8_SB(0, 1), cB + hstep, voffB); PG8_STAGE(PG8_SA(0, 1), cA + hstep, voffA);
        if (wr == 1) PG8_BAR;
        PG8_WAIT_V(4); PG8_BAR;
        PG8_STAGE(PG8_SB(1, 0), cB + kstep, voffB); PG8_STAGE(PG8_SA(1, 0), cA + kstep, voffA); PG8_STAGE(PG8_SB(1, 1), cB + hstep + kstep, voffB);
        PG8_WAIT_V(6); PG8_BAR;
    }
    for (;;) {
        const bool has_next = S.next(ui + 1, nxt);
        const char* nA = has_next ? (const char*)g.A + (size_t)nxt.pm * tstep + (size_t)nxt.kc * g.K * 2 : cA; const char* nB = has_next ? (const char*)g.Bt + (size_t)nxt.pn * tstep + (size_t)nxt.kc * g.K * 2 : cB;
        for (int t = 0; t < nt; t += 2) {
            const bool last = (t == nt - 2);
            const char* a1 = cA + (size_t)(t + 1) * kstep;
            const char* a2 = last ? nA : cA + (size_t)(t + 2) * kstep; const char* b2 = last ? nB : cB + (size_t)(t + 2) * kstep;
            const char* a3 = a2 + kstep; const char* b3 = b2 + kstep;
            if (last && has_next) S.a_ready(nxt);
            if constexpr (SP2) {
            PG8_LDB(B0, 0, 0); PG8_LDB(B1, 0, 1); PG8_SCHED; PG8_LDA(At, 0, 0); PG8_STAGE(PG8_SA(1, 1), a1 + hstep, voffA);
            PG8_WAIT_V(8); PG8_WAIT_L(0); PG8_BAR; PG8_MMA(0, 0, At, B0); PG8_MMA(0, 1, At, B1); PG8_BAR; PG8_SCHED;
            if constexpr (!HALFM) PG8_LDA(At, 0, 1); PG8_STAGE(PG8_SB(0, 0), b2, voffB); PG8_STAGE(PG8_SB(0, 1), b2 + hstep, voffB); PG8_STAGE(PG8_SA(0, 0), a2, voffA);
            PG8_WAIT_V(8); PG8_WAIT_L(0); PG8_BAR; if constexpr (!HALFM) { PG8_MMA(1, 0, At, B0); PG8_MMA(1, 1, At, B1); } PG8_BAR; PG8_SCHED;
            PG8_LDB(B0, 1, 0); PG8_LDB(B1, 1, 1); PG8_SCHED; PG8_LDA(At, 1, 0); PG8_STAGE(PG8_SA(0, 1), a2 + hstep, voffA);
            PG8_WAIT_V(8); PG8_WAIT_L(0); PG8_BAR; PG8_MMA(0, 0, At, B0); PG8_MMA(0, 1, At, B1); PG8_BAR; PG8_SCHED;
            if constexpr (!HALFM) PG8_LDA(At, 1, 1); PG8_STAGE(PG8_SB(1, 0), b3, voffB); PG8_STAGE(PG8_SB(1, 1), b3 + hstep, voffB); PG8_STAGE(PG8_SA(1, 0), a3, voffA);
            PG8_WAIT_V(8); PG8_WAIT_L(0); PG8_BAR; if constexpr (!HALFM) { PG8_MMA(1, 0, At, B0); PG8_MMA(1, 1, At, B1); } PG8_BAR; PG8_SCHED;
            } else {
            PG8_LDB(B0, 0, 0); PG8_SCHED; PG8_LDA(At, 0, 0); PG8_STAGE(PG8_SA(1, 1), a1 + hstep, voffA);
            PG8_WAIT_L(8); PG8_BAR; PG8_WAIT_L(0); PG8_MMA(0, 0, At, B0); PG8_BAR; PG8_SCHED;
            PG8_LDB(B1, 0, 1); PG8_STAGE(PG8_SB(0, 0), b2, voffB);
            PG8_BAR; PG8_WAIT_L(0); PG8_MMA(0, 1, At, B1); PG8_BAR;
            PG8_LDA(At, 0, 1); PG8_STAGE(PG8_SA(0, 0), a2, voffA);
            PG8_BAR; PG8_WAIT_L(0); PG8_MMA(1, 0, At, B0); PG8_BAR; PG8_SCHED;
            PG8_STAGE(PG8_SB(0, 1), b2 + hstep, voffB);
            PG8_WAIT_V(6); PG8_BAR; PG8_MMA(1, 1, At, B1); PG8_BAR;
            PG8_LDB(B0, 1, 0); PG8_SCHED; PG8_LDA(At, 1, 0); PG8_STAGE(PG8_SA(0, 1), a2 + hstep, voffA);
            PG8_WAIT_L(8); PG8_BAR; PG8_WAIT_L(0); PG8_MMA(0, 0, At, B0); PG8_BAR; PG8_SCHED;
            PG8_LDB(B1, 1, 1); PG8_STAGE(PG8_SB(1, 0), b3, voffB);
            PG8_BAR; PG8_WAIT_L(0); PG8_MMA(0, 1, At, B1); PG8_BAR;
            PG8_LDA(At, 1, 1); PG8_STAGE(PG8_SA(1, 0), a3, voffA);
            PG8_BAR; PG8_WAIT_L(0); PG8_MMA(1, 0, At, B0); PG8_BAR; PG8_SCHED;
            PG8_STAGE(PG8_SB(1, 1), b3 + hstep, voffB);
            PG8_WAIT_V(6); PG8_BAR; PG8_MMA(1, 1, At, B1); PG8_BAR;
            }
        }
        if constexpr (ALIGN_EPI) { if (wr == 0) PG8_BAR; }
        if constexpr (!Epi::AFTER_DRAIN) { int fr_ = fr, fq_ = fq; asm volatile("" : "+v"(fr_), "+v"(fq_));
            E(acc, cur, wr, wc, fr_, fq_); S.done(cur); }
        if (!has_next) break;
#pragma unroll
        for (int a = 0; a < 2; ++a)
#pragma unroll
            for (int b = 0; b < 2; ++b)
#pragma unroll
                for (int m = 0; m < 4; ++m)
#pragma unroll
                    for (int n = 0; n < 2; ++n) acc[a][b][m][n] = (f32x4){0.f, 0.f, 0.f, 0.f};
        cur = nxt; cA = nA; cB = nB; ++ui;
        if constexpr (ALIGN_EPI) { if (wr == 1) PG8_BAR; }
    }
    PG8_WAIT_V(0);
    if constexpr (!ALIGN_EPI) { if (wr == 0) PG8_BAR; }
    PG8_BAR;
    if constexpr (Epi::AFTER_DRAIN) { E.fused(acc, cur, wr, wc, fr, fq, lds, wid, lane); S.done(cur); }
#undef PG8_SA
#undef PG8_SB
#undef PG8_STAGE
#undef PG8_LDA
#undef PG8_LDB
#undef PG8_MMA
#undef PG8_WAIT_V
#undef PG8_WAIT_L
#undef PG8_BAR
#undef PG8_SCHED
}
}
#ifndef MK_N_LAUNCHES
#define MK_N_LAUNCHES 1
#endif
#define LAS __attribute__((address_space(3)))
typedef unsigned short bf16_t;
typedef short bf16x8 __attribute__((ext_vector_type(8)));
typedef float f32x4 __attribute__((ext_vector_type(4)));
typedef float f32x16 __attribute__((ext_vector_type(16)));
typedef unsigned u32x4 __attribute__((ext_vector_type(4)));
typedef unsigned u32x2 __attribute__((ext_vector_type(2)));
using pg8::cvt_pk_bf16;

constexpr int DM = 1024, NB = 16, SEQ = 2048, SBT = 8, STT = 16;
constexpr int MP = NB * SEQ, MS = SBT * STT, MR = MP + MS, MT = 33024, NPAN = MT / 256;
constexpr int DFF = 2816, DIN = 4096, NG = 32;
constexpr float RMS_EPS = 1e-6f;
constexpr float LOG2E = 1.4426950408889634f;
constexpr float QSCALE = 0.125f * LOG2E;
constexpr size_t O_YP = 0, O_YS = O_YP + (size_t)MP * DM, O_SREP = O_YS + (size_t)MS * DM, O_SIMP = O_SREP + NB * 32 * 64, O_KP = O_SIMP + NB * 32 * 64,
                 O_VP = O_KP + (size_t)NB * 512 * 512, O_CP = O_VP + (size_t)NB * 512 * 512, O_SRES = O_CP + NB * 2 * DFF, O_SIMS = O_SRES + SBT * 32 * 64,
                 O_KS = O_SIMS + SBT * 32 * 64, O_VS = O_KS + MS * 512, O_CS = O_VS + MS * 512, O_END = O_CS + SBT * 2 * DFF;
constexpr size_t MiB = 1u << 20;
constexpr size_t WS_CTL = 0, CTL_BYTES = 1 * MiB;
constexpr size_t CTL_BAR = 768 * 1024;
constexpr size_t CTL_SSQ2 = 4096, CTL_SSQ3 = 4096 + 256 * 1024;
constexpr size_t WS_WIN = 1 * MiB, WS_WGLU = 9 * MiB, WS_WAU = 11 * MiB, WS_WO = 12 * MiB, WS_WUP = 14 * MiB, WS_WDN = 25 * MiB;
constexpr size_t WS_BBAR = 31 * MiB, WS_CMAT = WS_BBAR + 131072, WS_LAMB = WS_CMAT + 131072;
constexpr size_t WS_XN = 32 * MiB;
constexpr size_t WS_U = 97 * MiB, WS_Q = 130 * MiB, WS_KB = 163 * MiB, WS_VT = 196 * MiB, WS_SG = 229 * MiB, WS_SA = 294 * MiB, WS_YS = 359 * MiB, WS_ATT = 392 * MiB;
constexpr size_t WS_HB = 97 * MiB;
constexpr size_t WS_G = 163 * MiB;
constexpr size_t WS_HALO = 425 * MiB, WS_SIDEA = 437 * MiB, WS_SIDEB = 449 * MiB, WS_END = 461 * MiB;
static_assert(WS_G + (size_t)MT * DFF * 2 <= WS_YS && WS_HB + (size_t)MT * DM * 2 <= WS_KB && WS_XN + (size_t)MT * DM * 2 <= WS_U, "ws map");
static_assert(CTL_SSQ3 + MT * 4 <= CTL_BYTES && (size_t)516 * 2 * DFF * 4 <= 12 * MiB, "ws map 2");
constexpr int LDS_BYTES = 147456;

__device__ __forceinline__ float bf2f(unsigned short b) { return __uint_as_float(((unsigned)b) << 16); }
__device__ __forceinline__ float bflo(unsigned w) { return __uint_as_float(w << 16); }
__device__ __forceinline__ float bfhi(unsigned w) { return __uint_as_float(w & 0xffff0000u); }
__device__ __forceinline__ float ex2(float x) { return __builtin_amdgcn_exp2f(x); }
__device__ __forceinline__ float sigm(float x) { return __builtin_amdgcn_rcpf(1.f + ex2(-LOG2E * x)); }
__device__ __forceinline__ float gelu_t(float x) { const float z = 1.5957691216057308f * (x + 0.044715f * x * x * x); return x * sigm(z); }
__device__ __forceinline__ float* hrow(float* out, int row) { return row < MP ? out + O_YP + (size_t)row * DM : out + O_YS + (size_t)(row - MP) * DM; }

#define ACC_T const f32x4 (&acc)[2][2][4][2]
#define EPI_STATICS static constexpr bool PERM = true, AFTER_DRAIN = false;
__device__ __forceinline__ u32x4 pack8(const f32x4 a, const f32x4 b) { u32x4 w; w.x = cvt_pk_bf16(a[0], a[1]); w.y = cvt_pk_bf16(a[2], a[3]); w.z = cvt_pk_bf16(b[0], b[1]); w.w = cvt_pk_bf16(b[2], b[3]); return w; }

struct EpiIn {
    EPI_STATICS
    bf16_t *U, *Q, *KB, *VT, *SG, *SA; float* out;
    __device__ __forceinline__ void operator()(ACC_T, const pg8::Unit& u, int wr, int wc, int fr, int fq) const {
        const int pn = u.pn;
#pragma unroll
        for (int ai = 0; ai < 2; ++ai)
#pragma unroll
            for (int m = 0; m < 4; ++m) {
                const int row = u.pm * 256 + ai * 128 + wr * 64 + m * 16 + fr;
                if (row >= MR) continue;
#pragma unroll
                for (int bj = 0; bj < 2; ++bj) {
                    const int c = pn * 256 + bj * 128 + wc * 32 + 8 * fq;
                    f32x4 v0 = acc[ai][bj][m][0], v1 = acc[ai][bj][m][1];
                    if (pn < 2) { *(u32x4*)(U + ((size_t)(c >> 4) * MT + row) * 16 + (c & 8)) = pack8(v0, v1); }
                    else if (pn < 4) { *(u32x4*)(Q + (size_t)row * 512 + (c - 512)) = pack8(v0 * QSCALE, v1 * QSCALE); }
                    else if (pn < 8) {
                        const bool isv = pn >= 6; const int cc = c - (isv ? 1536 : 1024);
                        float* fo = nullptr;
                        if (row >= MP) fo = out + (isv ? O_VS : O_KS) + (size_t)(row - MP) * 512 + cc;
                        else { const int t = row & 2047, nb = row >> 11; if (t >= 1536) fo = out + (isv ? O_VP : O_KP) + ((size_t)(nb * 512 + t - 1536)) * 512 + cc; }
                        if (fo) { *(f32x4*)fo = v0; *(f32x4*)(fo + 4) = v1; }
                        if (!isv) {
                            if (row < MP) { const int t = row & 2047, nb = row >> 11, hh = cc >> 6, dch = (cc & 63) >> 3, kl = t & 31, pos = (kl & ~12) | ((kl & 4) << 1) | ((kl & 8) >> 1);
                                *(u32x4*)(KB + (((size_t)(nb * 8 + hh) * 64 + (t >> 5)) * 8 + dch) * 256 + pos * 8) = pack8(v0, v1); } }
                        else if (row < MP) {
                            const int t = row & 2047, nb = row >> 11, hh = cc >> 6, d = cc & 63;
                            bf16_t* vp = VT + ((size_t)(nb * 8 + hh) * 64 + (t >> 5)) * 2048 + (((d >> 5) * 2 + ((t >> 4) & 1)) * 2 + ((t >> 3) & 1)) * 256 + (d & 31) * 8 + (t & 7);
                            const u32x4 w = pack8(v0, v1);
                            vp[0] = (bf16_t)(w.x & 0xffff); vp[8] = (bf16_t)(w.x >> 16); vp[16] = (bf16_t)(w.y & 0xffff); vp[24] = (bf16_t)(w.y >> 16);
                            vp[32] = (bf16_t)(w.z & 0xffff); vp[40] = (bf16_t)(w.z >> 16); vp[48] = (bf16_t)(w.w & 0xffff); vp[56] = (bf16_t)(w.w >> 16);
                        }
                    } else {
                        bf16_t* dst = (pn < 12) ? SG + (size_t)row * 1024 + (c - 2048) : SA + (size_t)row * 1024 + (c - 3072);
#pragma unroll
                        for (int e = 0; e < 4; ++e) { v0[e] = sigm(v0[e]); v1[e] = sigm(v1[e]); }
                        *(u32x4*)dst = pack8(v0, v1);
                    }
                }
            }
    }
};

struct EpiAttUp {
    EPI_STATICS
    const bf16_t* SA; bf16_t* T1;
    __device__ __forceinline__ void operator()(ACC_T, const pg8::Unit& u, int wr, int wc, int fr, int fq) const {
#pragma unroll
        for (int ai = 0; ai < 2; ++ai)
#pragma unroll
            for (int m = 0; m < 4; ++m) {
                const int row = u.pm * 256 + ai * 128 + wr * 64 + m * 16 + fr;
                if (row >= MR) continue;
#pragma unroll
                for (int bj = 0; bj < 2; ++bj) {
                    const size_t off = (size_t)row * 1024 + u.pn * 256 + bj * 128 + wc * 32 + 8 * fq;
                    const u32x4 s = *(const u32x4*)(SA + off);
                    f32x4 v0 = acc[ai][bj][m][0], v1 = acc[ai][bj][m][1];
                    v0[0] *= bflo(s.x); v0[1] *= bfhi(s.x); v0[2] *= bflo(s.y); v0[3] *= bfhi(s.y);
                    v1[0] *= bflo(s.z); v1[1] *= bfhi(s.z); v1[2] *= bflo(s.w); v1[3] *= bfhi(s.w);
                    *(u32x4*)(T1 + off) = pack8(v0, v1);
                }
            }
    }
};

struct EpiGlu {
    EPI_STATICS
    const bf16_t* SG; bf16_t* MIX;
    __device__ __forceinline__ void operator()(ACC_T, const pg8::Unit& u, int wr, int wc, int fr, int fq) const {
#pragma unroll
        for (int ai = 0; ai < 2; ++ai)
#pragma unroll
            for (int m = 0; m < 4; ++m) {
                const int row = u.pm * 256 + ai * 128 + wr * 64 + m * 16 + fr;
                if (row >= MR) continue;
                const size_t off = (size_t)row * 1024 + u.pn * 128 + wc * 32 + 8 * fq;
                const u32x4 s = *(const u32x4*)(SG + off), t = *(const u32x4*)(MIX + off);
                f32x4 v0 = acc[ai][0][m][0], v1 = acc[ai][0][m][1]; const f32x4 g0 = acc[ai][1][m][0], g1 = acc[ai][1][m][1];
#pragma unroll
                for (int e = 0; e < 4; ++e) { v0[e] *= sigm(g0[e]); v1[e] *= sigm(g1[e]); }
                v0[0] = bflo(t.x) + bflo(s.x) * v0[0]; v0[1] = bfhi(t.x) + bfhi(s.x) * v0[1]; v0[2] = bflo(t.y) + bflo(s.y) * v0[2]; v0[3] = bfhi(t.y) + bfhi(s.y) * v0[3];
                v1[0] = bflo(t.z) + bflo(s.z) * v1[0]; v1[1] = bfhi(t.z) + bfhi(s.z) * v1[1]; v1[2] = bflo(t.w) + bflo(s.w) * v1[2]; v1[3] = bfhi(t.w) + bfhi(s.w) * v1[3];
                *(u32x4*)(MIX + off) = pack8(v0, v1);
            }
    }
};

template <bool FIRST> struct EpiRes {
    EPI_STATICS
    const float *xp, *xs; float* out; bf16_t* HB; float* ssq;
    __device__ __forceinline__ void operator()(ACC_T, const pg8::Unit& u, int wr, int wc, int fr, int fq) const {
#pragma unroll
        for (int ai = 0; ai < 2; ++ai)
#pragma unroll
            for (int m = 0; m < 4; ++m) {
                const int row = u.pm * 256 + ai * 128 + wr * 64 + m * 16 + fr;
                float sq = 0.f;
                if (row < MR) {
                    float* hp = hrow(out, row);
                    const float* bp = FIRST ? (row < MP ? xp + (size_t)row * DM : xs + (size_t)(row - MP) * DM) : hp;
#pragma unroll
                    for (int bj = 0; bj < 2; ++bj) {
                        const int c = u.pn * 256 + bj * 128 + wc * 32 + 8 * fq;
                        const f32x4 h0 = *(const f32x4*)(bp + c) + acc[ai][bj][m][0], h1 = *(const f32x4*)(bp + c + 4) + acc[ai][bj][m][1];
                        *(f32x4*)(hp + c) = h0; *(f32x4*)(hp + c + 4) = h1;
                        if (FIRST) *(u32x4*)(HB + (size_t)row * DM + c) = pack8(h0, h1);
                        sq += (h0[0] * h0[0] + h0[1] * h0[1]) + (h0[2] * h0[2] + h0[3] * h0[3]) + (h1[0] * h1[0] + h1[1] * h1[1]) + (h1[2] * h1[2] + h1[3] * h1[3]);
                    }
                }
                if (FIRST) { sq += __shfl_xor(sq, 16); sq += __shfl_xor(sq, 32); if (fq == 0 && row < MR) unsafeAtomicAdd(ssq + row, sq); }
            }
    }
};

struct EpiAddSample {
    EPI_STATICS
    float* out;
    __device__ __forceinline__ void operator()(ACC_T, const pg8::Unit& u, int wr, int wc, int fr, int fq) const {
#pragma unroll
        for (int m = 0; m < 4; ++m) {
            const int row = u.pm * 256 + wr * 64 + m * 16 + fr;
            float* hp = hrow(out, row);
#pragma unroll
            for (int bj = 0; bj < 2; ++bj) {
                const int c = u.pn * 256 + bj * 128 + wc * 32 + 8 * fq;
#pragma unroll
                for (int e = 0; e < 4; ++e) { unsafeAtomicAdd(hp + c + e, acc[0][bj][m][0][e]); unsafeAtomicAdd(hp + c + 4 + e, acc[0][bj][m][1][e]); }
            }
        }
    }
};

struct EpiUp {
    EPI_STATICS
    bf16_t* G; float *HALO, *SIDEA, *SIDEB; const float *ssq, *taps, *cbias, *cconv; float* out;
    static __device__ __forceinline__ float dpp_shr1(float old, float v) { return __builtin_bit_cast(float, __builtin_amdgcn_update_dpp(__builtin_bit_cast(int, old), __builtin_bit_cast(int, v), 0x111, 0xf, 0xf, false)); }
    static __device__ __forceinline__ float dpp_shr2(float old, float v) { return __builtin_bit_cast(float, __builtin_amdgcn_update_dpp(__builtin_bit_cast(int, old), __builtin_bit_cast(int, v), 0x112, 0xf, 0xf, false)); }
    static __device__ __forceinline__ float dpp_ror1(float v) { return __builtin_bit_cast(float, __builtin_amdgcn_update_dpp(0, __builtin_bit_cast(int, v), 0x121, 0xf, 0xf, false)); }
    static __device__ __forceinline__ float dpp_ror2(float v) { return __builtin_bit_cast(float, __builtin_amdgcn_update_dpp(0, __builtin_bit_cast(int, v), 0x122, 0xf, 0xf, false)); }
    __device__ __forceinline__ void operator()(ACC_T, const pg8::Unit& u, int wr, int wc, int fr, int fq) const {
        const int pm = u.pm; const bool samp = (pm == NPAN - 1);
        const int c0 = u.pn * 128 + wc * 32 + 8 * fq;
        f32x4 t0[2], t1[2], t2[2], cb[2];
#pragma unroll
        for (int n = 0; n < 2; ++n) { t0[n] = *(const f32x4*)(taps + c0 + 4 * n); t1[n] = *(const f32x4*)(taps + DFF + c0 + 4 * n); t2[n] = *(const f32x4*)(taps + 2 * DFF + c0 + 4 * n); cb[n] = *(const f32x4*)(cbias + c0 + 4 * n); }
#pragma unroll
        for (int ai = 0; ai < 2; ++ai) {
            float rs[4];
#pragma unroll
            for (int m = 0; m < 4; ++m) rs[m] = 1.0f / sqrtf(ssq[pm * 256 + ai * 128 + wr * 64 + m * 16 + fr] * (1.0f / DM) + RMS_EPS);
            f32x4 prev[2] = {(f32x4){0.f, 0.f, 0.f, 0.f}, (f32x4){0.f, 0.f, 0.f, 0.f}};
#pragma unroll
            for (int m = 0; m < 4; ++m) {
                const int row = pm * 256 + ai * 128 + wr * 64 + m * 16 + fr;
                f32x4 g[2], av[2], bv[2];
#pragma unroll
                for (int n = 0; n < 2; ++n) {
                    av[n] = acc[ai][0][m][n] * rs[m]; bv[n] = acc[ai][1][m][n] * rs[m];
                    if (samp) { prev[n] = (f32x4){0.f, 0.f, 0.f, 0.f}; if (ai == 0 && fr >= 14) prev[n] = *(const f32x4*)(cconv + ((size_t)(4 * wr + m) * 2 + (fr - 14)) * DFF + c0 + 4 * n); }
#pragma unroll
                    for (int e = 0; e < 4; ++e) {
                        const float a1 = dpp_shr1(dpp_ror1(prev[n][e]), av[n][e]), a2 = dpp_shr2(dpp_ror2(prev[n][e]), av[n][e]);
                        g[n][e] = gelu_t(cb[n][e] + t0[n][e] * a2 + t1[n][e] * a1 + t2[n][e] * av[n][e]) * bv[n][e];
                    }
                    prev[n] = av[n];
                }
                if (row < MR) *(u32x4*)(G + (size_t)row * DFF + c0) = pack8(g[0], g[1]);
                if (!samp) {
                    const int blk = row >> 6;
                    if (m == 0 && fr < 2) {
#pragma unroll
                        for (int n = 0; n < 2; ++n) { *(f32x4*)(SIDEA + ((size_t)blk * 2 + fr) * DFF + c0 + 4 * n) = av[n]; *(f32x4*)(SIDEB + ((size_t)blk * 2 + fr) * DFF + c0 + 4 * n) = bv[n]; } }
                    if (m == 3 && fr >= 14) {
#pragma unroll
                        for (int n = 0; n < 2; ++n) *(f32x4*)(HALO + ((size_t)blk * 2 + (fr - 14)) * DFF + c0 + 4 * n) = av[n]; }
                } else if (ai == 0 && fr >= 14) {
#pragma unroll
                    for (int n = 0; n < 2; ++n) *(f32x4*)(out + O_CS + ((size_t)(4 * wr + m) * 2 + (fr - 14)) * DFF + c0 + 4 * n) = av[n]; }
            }
        }
    }
};
__device__ __forceinline__ unsigned f2bf(float f) { unsigned u = __builtin_bit_cast(unsigned, f); return (u + 0x7fffu + ((u >> 16) & 1u)) >> 16; }
__device__ __forceinline__ unsigned pk2(float lo, float hi) { return f2bf(lo) | (f2bf(hi) << 16); }
__device__ __forceinline__ float wave_sum(float v) {
#pragma unroll
    for (int o = 1; o < 64; o <<= 1) v += __shfl_xor(v, o);
    return v;
}
__device__ __forceinline__ void p0_transpose_item(const float* W, int K, int N, bf16_t* WT, LAS float* scr, int item, int lane, const float* g, bool ilv) {
    const int nblk = N / 32, kb = item / nblk, nb = item % nblk, k0 = 64 * kb, n0 = 32 * nb;
    {
        const int r8 = lane >> 3, c4 = (lane & 7) * 4;
        f32x4 v[8];
#pragma unroll
        for (int i = 0; i < 8; ++i) v[i] = *(const f32x4*)(W + (size_t)(k0 + 8 * i + r8) * N + n0 + c4);
#pragma unroll
        for (int i = 0; i < 8; ++i) { const int kk = 8 * i + r8; if (g) v[i] = v[i] * g[k0 + kk];
            scr[kk * 33 + c4] = v[i][0]; scr[kk * 33 + c4 + 1] = v[i][1]; scr[kk * 33 + c4 + 2] = v[i][2]; scr[kk * 33 + c4 + 3] = v[i][3]; }
    }
    asm volatile("s_waitcnt lgkmcnt(0)" ::: "memory");
    int d0 = n0;
    if (ilv) { const int hn = N / 2; d0 = (n0 < hn) ? 256 * (n0 / 128) + (n0 % 128) : 256 * ((n0 - hn) / 128) + 128 + ((n0 - hn) % 128); }
    const int c = lane & 7;
#pragma unroll
    for (int j = 0; j < 4; ++j) { const int n = (lane >> 3) + 8 * j; const LAS float* s = scr + (8 * c) * 33 + n;
        u32x4 o; o.x = pk2(s[0 * 33], s[1 * 33]); o.y = pk2(s[2 * 33], s[3 * 33]); o.z = pk2(s[4 * 33], s[5 * 33]); o.w = pk2(s[6 * 33], s[7 * 33]);
        *(u32x4*)(WT + (size_t)(d0 + n) * K + k0 + 8 * c) = o; }
    asm volatile("s_waitcnt lgkmcnt(0)" ::: "memory");
}
__device__ __forceinline__ void sincos_d(double x, double& s, double& c) {
    const double TWO_PI = 6.283185307179586476925287, INV = 0.159154943091895335768884;
    const double k = __builtin_rint(x * INV); double r = __builtin_fma(-k, TWO_PI, x); r = __builtin_fma(-k, -2.4492935982947064e-16, r);
    const double r2 = r * r; double ts = 1.0, tc = 1.0, ss = 1.0, cc = 1.0;
#pragma unroll
    for (int i = 1; i <= 14; ++i) { tc = -tc * r2 / (double)((2 * i - 1) * (2 * i)); cc += tc; ts = -ts * r2 / (double)((2 * i) * (2 * i + 1)); ss += ts; }
    s = r * ss; c = cc;
}
__device__ __forceinline__ double exp_small_d(double x) {
    double t = 1.0, acc = 1.0;
#pragma unroll
    for (int i = 1; i <= 12; ++i) { t = t * x / (double)i; acc += t; }
    return acc;
}
struct P {
    const float* in[27]; float* out; unsigned char* ws;
};
__device__ __forceinline__ void p0_prologue(const P& p, LAS unsigned char* lds, int vb, int G, int wave, int lane) {
    LAS float* scr = (LAS float*)(lds + wave * 16384);
    const int gw = vb * 8 + wave, NGW = G * 8;
    unsigned char* ws = p.ws;
    constexpr int I_IN = 16 * 128, I_GLU = 8 * 64, I_AU = 8 * 32, I_O = 16 * 32, I_UP = 16 * 176, I_DN = 44 * 32;
    constexpr int NITEMS = I_IN + I_GLU + I_AU + I_O + I_UP + I_DN;
    for (int it = gw; it < NITEMS; it += NGW) {
        int r = it;
        if (r < I_IN) { p0_transpose_item(p.in[8], 1024, 4096, (bf16_t*)(ws + WS_WIN), scr, r, lane, nullptr, false); continue; } r -= I_IN;
        if (r < I_GLU) { p0_transpose_item(p.in[17], 512, 2048, (bf16_t*)(ws + WS_WGLU), scr, r, lane, nullptr, true); continue; } r -= I_GLU;
        if (r < I_AU) { p0_transpose_item(p.in[19], 512, 1024, (bf16_t*)(ws + WS_WAU), scr, r, lane, nullptr, false); continue; } r -= I_AU;
        if (r < I_O) { p0_transpose_item(p.in[20], 1024, 1024, (bf16_t*)(ws + WS_WO), scr, r, lane, nullptr, false); continue; } r -= I_O;
        if (r < I_UP) { p0_transpose_item(p.in[22], 1024, 5632, (bf16_t*)(ws + WS_WUP), scr, r, lane, p.in[21], true); continue; } r -= I_UP;
        p0_transpose_item(p.in[25], 2816, 1024, (bf16_t*)(ws + WS_WDN), scr, r, lane, nullptr, false);
    }
    const float* gm = p.in[7];
    f32x4 gv[4];
#pragma unroll
    for (int j = 0; j < 4; ++j) gv[j] = *((const f32x4*)gm + lane + 64 * j);
    bf16_t* XN = (bf16_t*)(ws + WS_XN);
    for (int m = gw; m < MT; m += NGW) {
        unsigned long long* o8 = (unsigned long long*)(XN + (size_t)m * DM) + lane;
        if (m >= MR) {
#pragma unroll
            for (int j = 0; j < 4; ++j) o8[64 * j] = 0ull;
            continue; }
        const f32x4* xr = (const f32x4*)(m < MP ? p.in[0] + (size_t)m * DM : p.in[1] + (size_t)(m - MP) * DM) + lane;
        f32x4 v[4]; float s = 0.f;
#pragma unroll
        for (int j = 0; j < 4; ++j) { v[j] = xr[64 * j]; s += (v[j].x * v[j].x + v[j].y * v[j].y) + (v[j].z * v[j].z + v[j].w * v[j].w); }
        const float rstd = 1.0f / sqrtf(wave_sum(s) * (1.f / DM) + RMS_EPS);
#pragma unroll
        for (int j = 0; j < 4; ++j) { const f32x4 y = v[j] * rstd * gv[j]; o8[64 * j] = (unsigned long long)pk2(y.x, y.y) | ((unsigned long long)pk2(y.z, y.w) << 32); }
    }
    const int gt = gw * 64 + lane;
    if (gt < NG * 64) {
        const int g = gt >> 6, pp = gt & 63;
        const double lr = (double)p.in[9][gt], li = (double)p.in[10][gt];
        const double dt = (double)expf(p.in[11][g]);
        double sn, cs; sincos_d(li * dt, sn, cs);
        const double er = exp_small_d(lr * dt);
        const double ar = er * cs, ai = er * sn;
        const double den = lr * lr + li * li;
        const double cr = ((ar - 1.0) * lr + ai * li) / den, ci = (ai * lr - (ar - 1.0) * li) / den;
        float* LAMB = (float*)(ws + WS_LAMB); LAMB[gt * 2] = (float)ar; LAMB[gt * 2 + 1] = (float)ai;
        bf16_t* BB = (bf16_t*)(ws + WS_BBAR); bf16_t* CM = (bf16_t*)(ws + WS_CMAT);
        for (int h = 0; h < 16; ++h) {
            const double br = (double)p.in[12][(size_t)gt * 16 + h], bi = (double)p.in[13][(size_t)gt * 16 + h];
            BB[((size_t)(g * 2 + 0) * 64 + pp) * 16 + h] = (bf16_t)f2bf((float)(cr * br - ci * bi));
            BB[((size_t)(g * 2 + 1) * 64 + pp) * 16 + h] = (bf16_t)f2bf((float)(cr * bi + ci * br));
            CM[((size_t)g * 16 + h) * 128 + 2 * pp] = (bf16_t)f2bf(p.in[14][((size_t)g * 16 + h) * 64 + pp]);
            CM[((size_t)g * 16 + h) * 128 + 2 * pp + 1] = (bf16_t)f2bf(-p.in[15][((size_t)g * 16 + h) * 64 + pp]);
        }
    }
}

constexpr int SW_ROW = 336, SW_BYTES = 2 * 16 * SW_ROW;
constexpr int LDS_BT = 8 * SW_BYTES;
struct S5Ctx { bf16x8 Bf[2][2], Cf[5]; float lrb[2], lib[2]; };
__device__ __forceinline__ void s5_setup(const P& p, S5Ctx& c, int g, int lane) {
    unsigned char* ws = p.ws; const int col = lane & 31, hi = lane >> 5;
    const bf16_t* BB = (const bf16_t*)(ws + WS_BBAR); const bf16_t* CM = (const bf16_t*)(ws + WS_CMAT); const float* LAMB = (const float*)(ws + WS_LAMB);
#pragma unroll
    for (int cc = 0; cc < 2; ++cc)
#pragma unroll
        for (int pt = 0; pt < 2; ++pt) c.Bf[cc][pt] = *(const bf16x8*)(BB + ((size_t)(g * 2 + cc) * 64 + 32 * pt + col) * 16 + 8 * hi);
#pragma unroll
    for (int ks = 0; ks < 4; ++ks) c.Cf[ks] = *(const bf16x8*)(CM + ((size_t)g * 16 + (lane & 15)) * 128 + 32 * ks + 8 * (lane >> 4));
    {
        const short dbf = (short)f2bf(p.in[16][g * 16 + (lane & 15)]); const int kq = lane >> 4, hh = lane & 15;
#pragma unroll
        for (int j = 0; j < 8; ++j) c.Cf[4][j] = (kq < 2 && 8 * kq + j == hh) ? dbf : (short)0;
    }
#pragma unroll
    for (int pt = 0; pt < 2; ++pt) { const int pp = 32 * pt + col; c.lrb[pt] = LAMB[(g * 64 + pp) * 2]; c.lib[pt] = LAMB[(g * 64 + pp) * 2 + 1]; }
}
template <bool DO_Y> __device__ __forceinline__ void s5_scan(const P& p, const S5Ctx& c, LAS unsigned char* sw, int g, size_t rb0, size_t rb1, int nit, float (&sr)[2], float (&si)[2], int lane) {
    const bf16_t* U = (const bf16_t*)(p.ws + WS_U); bf16_t* YS = (bf16_t*)(p.ws + WS_YS);
    const int col = lane & 31, hi = lane >> 5;
    if (DO_Y) { if (lane < 32) { *(LAS u32x4*)(sw + lane * SW_ROW + 288) = (u32x4){0u, 0u, 0u, 0u}; *(LAS u32x4*)(sw + lane * SW_ROW + 304) = (u32x4){0u, 0u, 0u, 0u}; } }
    const int rho = lane & 31; const int sA = (rho >> 2) & 1, tl = (rho & 3) + 4 * (rho >> 3);
    const bf16_t* ua_p = U + ((size_t)g * MT + (sA ? rb1 : rb0) + tl) * 16 + 8 * hi;
    LAS unsigned char* uw = sw + (sA * 16 + tl) * SW_ROW + 256 + 16 * hi;
    const f32x16 z16 = {0.f, 0.f, 0.f, 0.f, 0.f, 0.f, 0.f, 0.f, 0.f, 0.f, 0.f, 0.f, 0.f, 0.f, 0.f, 0.f};
    constexpr int PF = 4;
    bf16x8 ub[PF];
#pragma unroll
    for (int k = 0; k < PF; ++k) ub[k] = *(const bf16x8*)(ua_p + (size_t)(k < nit ? k : 0) * 16 * 16);
    for (int it0 = 0; it0 < nit; it0 += PF) {
#pragma unroll
        for (int k = 0; k < PF; ++k) {
            const int it = it0 + k;
            if (it < nit) {
                const bf16x8 ua = ub[k];
                { const int nx = it + PF; ub[k] = *(const bf16x8*)(ua_p + (size_t)(nx < nit ? nx : it) * 16 * 16); }
                if (DO_Y) *(LAS bf16x8*)uw = ua;
                f32x16 are[2], aim[2];
#pragma unroll
                for (int pt = 0; pt < 2; ++pt) { are[pt] = __builtin_amdgcn_mfma_f32_32x32x16_bf16(ua, c.Bf[0][pt], z16, 0, 0, 0); aim[pt] = __builtin_amdgcn_mfma_f32_32x32x16_bf16(ua, c.Bf[1][pt], z16, 0, 0, 0); }
                asm volatile("s_nop 15\n\ts_nop 15\n\ts_nop 15\n\ts_nop 15" ::: "memory");
#pragma unroll
                for (int r = 0; r < 16; ++r)
#pragma unroll
                    for (int pt = 0; pt < 2; ++pt) {
                        const float nr = __builtin_fmaf(c.lrb[pt], sr[pt], __builtin_fmaf(-c.lib[pt], si[pt], are[pt][r]));
                        const float ni = __builtin_fmaf(c.lrb[pt], si[pt], __builtin_fmaf(c.lib[pt], sr[pt], aim[pt][r]));
                        sr[pt] = nr; si[pt] = ni;
                        if (DO_Y) *(LAS unsigned*)(sw + (hi * 16 + r) * SW_ROW + (32 * pt + col) * 4) = cvt_pk_bf16(nr, ni);
                    }
                if (DO_Y) {
                    const int t0 = it * 16;
#pragma unroll
                    for (int s = 0; s < 2; ++s) {
                        f32x4 y = {0.f, 0.f, 0.f, 0.f};
                        bf16x8 af[5];
#pragma unroll
                        for (int ks = 0; ks < 5; ++ks) af[ks] = *(const LAS bf16x8*)(sw + (s * 16 + (lane & 15)) * SW_ROW + (32 * ks + 8 * (lane >> 4)) * 2);
                        asm volatile("s_waitcnt lgkmcnt(0)\n\ts_nop 7" ::: "memory");
#pragma unroll
                        for (int ks = 0; ks < 5; ++ks) y = __builtin_amdgcn_mfma_f32_16x16x32_bf16(af[ks], c.Cf[ks], y, 0, 0, 0);
                        asm volatile("s_nop 15\n\ts_nop 15" ::: "memory");
                        const size_t rb = (s ? rb1 : rb0) + t0 + 4 * (lane >> 4);
                        u32x2 w; w.x = cvt_pk_bf16(gelu_t(y[0]), gelu_t(y[1])); w.y = cvt_pk_bf16(gelu_t(y[2]), gelu_t(y[3]));
                        bf16_t* yo = YS + rb * 512 + 16 * g + (lane & 15);
                        yo[0] = (bf16_t)(w.x & 0xffff); yo[512] = (bf16_t)(w.x >> 16); yo[1024] = (bf16_t)(w.y & 0xffff); yo[1536] = (bf16_t)(w.y >> 16);
                    }
                }
            }
        }
    }
}
__device__ __forceinline__ void s5_sample_task(const P& p, LAS unsigned char* sw, int t2, int lane) {
    const int g = t2 & 31, n0 = 2 * (t2 >> 5), col = lane & 31, hi = lane >> 5;
    S5Ctx c; s5_setup(p, c, g, lane);
    float sr[2], si[2];
#pragma unroll
    for (int pt = 0; pt < 2; ++pt) { const size_t o = ((size_t)(n0 + hi) * 32 + g) * 64 + 32 * pt + col; sr[pt] = p.in[2][o]; si[pt] = p.in[3][o]; }
    const size_t rb0 = (size_t)MP + n0 * STT;
    s5_scan<true>(p, c, sw, g, rb0, rb0 + STT, 1, sr, si, lane);
#pragma unroll
    for (int pt = 0; pt < 2; ++pt) { const size_t o = ((size_t)(n0 + hi) * 32 + g) * 64 + 32 * pt + col; p.out[O_SRES + o] = sr[pt]; p.out[O_SIMS + o] = si[pt]; }
}
__device__ __forceinline__ void s5_prefix_task(const P& p, LAS unsigned char* sw, int bt, int seg, int lane) {
    const int g = bt & 31, n0 = 2 * (bt >> 5), col = lane & 31, hi = lane >> 5;
    S5Ctx c; s5_setup(p, c, g, lane);
    const size_t b0 = (size_t)n0 * SEQ;
    float sr[2] = {0.f, 0.f}, si[2] = {0.f, 0.f};
    s5_scan<false>(p, c, sw, g, b0, b0 + SEQ, 16 * seg, sr, si, lane);
    s5_scan<true>(p, c, sw, g, b0 + 256 * seg, b0 + SEQ + 256 * seg, 16, sr, si, lane);
    if (seg == 7) {
#pragma unroll
        for (int pt = 0; pt < 2; ++pt) { const size_t o = ((size_t)(n0 + hi) * 32 + g) * 64 + 32 * pt + col; p.out[O_SREP + o] = sr[pt]; p.out[O_SIMP + o] = si[pt]; }
    }
}
__device__ __forceinline__ void attn_task(const P& p, const LAS float* btab, int n, int c, int h, int lane) {
    unsigned char* ws = p.ws;
    const bf16_t* Q = (const bf16_t*)(ws + WS_Q); const bf16_t* KB = (const bf16_t*)(ws + WS_KB); const bf16_t* VT = (const bf16_t*)(ws + WS_VT); bf16_t* ATT = (bf16_t*)(ws + WS_ATT);
    const int q = lane & 31, hi = lane >> 5;
    const size_t rowq = (size_t)n * SEQ + 64 * c;
    bf16x8 qf[2][4];
#pragma unroll
    for (int qt = 0; qt < 2; ++qt)
#pragma unroll
        for (int ks = 0; ks < 4; ++ks) qf[qt][ks] = *(const bf16x8*)(Q + (rowq + 32 * qt + q) * 512 + 64 * h + 16 * ks + 8 * hi);
    f32x16 o[2][2];
#pragma unroll
    for (int a = 0; a < 2; ++a)
#pragma unroll
        for (int b = 0; b < 2; ++b)
#pragma unroll
            for (int r = 0; r < 16; ++r) o[a][b][r] = 0.f;
    float mrun[2] = {-1e30f, -1e30f}, lrun[2] = {0.f, 0.f};
    const int kstart = (c >= 8) ? 64 * (c - 8) : 0, kend = 64 * (c + 1);
    const bf16_t* kp = KB + (size_t)(n * 8 + h) * 64 * 2048 + hi * 256 + q * 8;
    const bf16_t* vp = VT + (size_t)(n * 8 + h) * 64 * 2048 + hi * 256 + q * 8;
    const LAS float* bt = btab + h * 257;
    bf16x8 kfn[4], vfn[2][2], kfm[4];
#pragma unroll
    for (int ks = 0; ks < 4; ++ks) { kfn[ks] = *(const bf16x8*)(kp + (size_t)(kstart >> 5) * 2048 + 512 * ks); kfm[ks] = *(const bf16x8*)(kp + (size_t)((kstart + 32) >> 5) * 2048 + 512 * ks); }
#pragma unroll
    for (int dt = 0; dt < 2; ++dt)
#pragma unroll
        for (int s = 0; s < 2; ++s) vfn[dt][s] = *(const bf16x8*)(vp + (size_t)(kstart >> 5) * 2048 + (dt * 2 + s) * 512);
    for (int kt = kstart; kt < kend; kt += 32) {
        bf16x8 kf[4], vf[2][2];
#pragma unroll
        for (int ks = 0; ks < 4; ++ks) { kf[ks] = kfn[ks]; kfn[ks] = kfm[ks]; }
#pragma unroll
        for (int dt = 0; dt < 2; ++dt)
#pragma unroll
            for (int s = 0; s < 2; ++s) vf[dt][s] = vfn[dt][s];
        { const int kn = (kt + 64 < kend) ? kt + 64 : kt, vn = (kt + 32 < kend) ? kt + 32 : kt;
#pragma unroll
        for (int ks = 0; ks < 4; ++ks) kfm[ks] = *(const bf16x8*)(kp + (size_t)(kn >> 5) * 2048 + 512 * ks);
#pragma unroll
        for (int dt = 0; dt < 2; ++dt)
#pragma unroll
            for (int s = 0; s < 2; ++s) vfn[dt][s] = *(const bf16x8*)(vp + (size_t)(vn >> 5) * 2048 + (dt * 2 + s) * 512); }
#pragma unroll
        for (int qt = 0; qt < 2; ++qt) {
            f32x16 st;
#pragma unroll
            for (int r = 0; r < 16; ++r) st[r] = 0.f;
            __builtin_amdgcn_s_setprio(1);
#pragma unroll
            for (int ks = 0; ks < 4; ++ks) st = __builtin_amdgcn_mfma_f32_32x32x16_bf16(kf[ks], qf[qt][ks], st, 0, 0, 0);
            __builtin_amdgcn_s_setprio(0);
            const int relmin = 64 * c + 32 * qt - kt - 31;
            if (relmin < 128) {
                const int relb = 64 * c + 32 * qt + q - kt;
#pragma unroll
                for (int r = 0; r < 16; ++r) { const int kl = (r & 3) + 4 * ((r >> 2) & 1) + 8 * hi + 16 * (r >> 3); int rel = relb - kl; rel = rel < -128 ? -128 : (rel > 128 ? 128 : rel); st[r] += bt[rel + 128]; }
            }
            float mx = st[0];
#pragma unroll
            for (int r = 1; r < 16; ++r) mx = fmaxf(mx, st[r]);
            mx = fmaxf(mx, __shfl_xor(mx, 32));
            const bool grow = mx > mrun[qt] + 8.0f;
            const float mnew = grow ? mx : mrun[qt];
            if (__builtin_amdgcn_ballot_w64(grow) != 0ull) {
                const float alpha = ex2(mrun[qt] - mnew);
                lrun[qt] *= alpha;
#pragma unroll
                for (int dt = 0; dt < 2; ++dt)
#pragma unroll
                    for (int r = 0; r < 16; ++r) o[dt][qt][r] *= alpha;
            }
            mrun[qt] = mnew;
            float ps = 0.f;
#pragma unroll
            for (int r = 0; r < 16; ++r) { st[r] = ex2(st[r] - mnew); ps += st[r]; }
            ps += __shfl_xor(ps, 32); lrun[qt] += ps;
            bf16x8 pf[2];
#pragma unroll
            for (int s = 0; s < 2; ++s) { u32x4 w; w.x = cvt_pk_bf16(st[8 * s], st[8 * s + 1]); w.y = cvt_pk_bf16(st[8 * s + 2], st[8 * s + 3]); w.z = cvt_pk_bf16(st[8 * s + 4], st[8 * s + 5]); w.w = cvt_pk_bf16(st[8 * s + 6], st[8 * s + 7]); pf[s] = __builtin_bit_cast(bf16x8, w); }
            __builtin_amdgcn_s_setprio(1);
#pragma unroll
            for (int dt = 0; dt < 2; ++dt)
#pragma unroll
                for (int s = 0; s < 2; ++s) o[dt][qt] = __builtin_amdgcn_mfma_f32_32x32x16_bf16(vf[dt][s], pf[s], o[dt][qt], 0, 0, 0);
            __builtin_amdgcn_s_setprio(0);
        }
    }
#pragma unroll
    for (int qt = 0; qt < 2; ++qt) {
        const float inv = 1.0f / lrun[qt];
        bf16_t* op = ATT + (rowq + 32 * qt + q) * 512 + 64 * h + 4 * hi;
#pragma unroll
        for (int dt = 0; dt < 2; ++dt)
#pragma unroll
            for (int rg = 0; rg < 4; ++rg) { u32x2 w; w.x = cvt_pk_bf16(o[dt][qt][4 * rg] * inv, o[dt][qt][4 * rg + 1] * inv); w.y = cvt_pk_bf16(o[dt][qt][4 * rg + 2] * inv, o[dt][qt][4 * rg + 3] * inv);
                *(u32x2*)(op + 32 * dt + 8 * rg) = w; }
    }
}

__device__ __forceinline__ void attn_sample_task(const P& p, const LAS float* btab, LAS float* pl, int task, int lane) {
    const int t = task & 15, h = (task >> 4) & 7, n = task >> 7;
    const bf16_t* Q = (const bf16_t*)(p.ws + WS_Q); bf16_t* ATT = (bf16_t*)(p.ws + WS_ATT);
    const size_t row = (size_t)MP + n * STT + t;
    const bf16_t* qp = Q + row * 512 + 64 * h;
    const float* ck = p.in[4]; const float* cv = p.in[5]; const float* nk = p.out + O_KS; const float* nv = p.out + O_VS;
    const LAS float* bt = btab + h * 257;
    const int kq_ = lane >> 4, d4_ = (lane & 15) * 4;
    const u32x2 qw = *(const u32x2*)(qp + d4_);
    const float q0 = bflo(qw.x), q1 = bfhi(qw.x), q2 = bflo(qw.y), q3 = bfhi(qw.y);
#pragma unroll 1
    for (int s0 = 0; s0 < 132; s0 += 22) {
        f32x4 kk[22];
#pragma unroll
        for (int s = 0; s < 22; ++s) { const int j = 4 * (s0 + s) + kq_;
            const float* kr = (j < 512) ? ck + (((size_t)n * 512 + j) * 8 + h) * 64 : nk + (((size_t)n * 16 + (j - 512)) * 8 + h) * 64; kk[s] = *(const f32x4*)(kr + d4_); }
#pragma unroll
        for (int s = 0; s < 22; ++s) {
            float part = (q0 * kk[s][0] + q1 * kk[s][1]) + (q2 * kk[s][2] + q3 * kk[s][3]);
            part += __shfl_xor(part, 1); part += __shfl_xor(part, 2); part += __shfl_xor(part, 4); part += __shfl_xor(part, 8);
            if ((lane & 15) == 0) { const int j = 4 * (s0 + s) + kq_; int rel = t + 512 - j; rel = rel > 128 ? 128 : (rel < -128 ? -128 : rel); pl[j] = part + bt[rel + 128]; }
        }
    }
    asm volatile("s_waitcnt lgkmcnt(0)" ::: "memory");
    float sc[9]; float mx = -1e30f;
#pragma unroll
    for (int i = 0; i < 9; ++i) { const int j = lane + 64 * i; sc[i] = (j < 528) ? pl[j] : -1e30f; mx = fmaxf(mx, sc[i]); }
#pragma unroll
    for (int o = 1; o < 64; o <<= 1) mx = fmaxf(mx, __shfl_xor(mx, o));
    float sum = 0.f;
#pragma unroll
    for (int i = 0; i < 9; ++i) { sc[i] = ex2(sc[i] - mx); sum += sc[i]; }
    sum = wave_sum(sum);
    f32x4 acc = {0.f, 0.f, 0.f, 0.f};
    const int kq = lane >> 4, d4 = (lane & 15) * 4;
#pragma unroll
    for (int i = 0; i < 9; ++i) if (i < 8 || lane < 16) pl[lane + 64 * i] = sc[i];
    asm volatile("s_waitcnt lgkmcnt(0)" ::: "memory");
#pragma unroll 1
    for (int s0 = 0; s0 < 132; s0 += 22) {
        f32x4 vv[22];
#pragma unroll
        for (int s = 0; s < 22; ++s) { const int j = 4 * (s0 + s) + kq;
            const float* vr = (j < 512) ? cv + (((size_t)n * 512 + j) * 8 + h) * 64 : nv + (((size_t)n * 16 + (j - 512)) * 8 + h) * 64; vv[s] = *(const f32x4*)(vr + d4); }
#pragma unroll
        for (int s = 0; s < 22; ++s) { const float pj = pl[4 * (s0 + s) + kq]; acc += vv[s] * pj; }
    }
#pragma unroll
    for (int e = 0; e < 4; ++e) { acc[e] += __shfl_xor(acc[e], 16); acc[e] += __shfl_xor(acc[e], 32); }
    if (kq == 0) { const float inv = 1.0f / sum; u32x2 w; w.x = cvt_pk_bf16(acc[0] * inv, acc[1] * inv); w.y = cvt_pk_bf16(acc[2] * inv, acc[3] * inv); *(u32x2*)(ATT + row * 512 + 64 * h + d4) = w; }
}
#define RLX_AGENT __ATOMIC_RELAXED, __HIP_MEMORY_SCOPE_AGENT
#define XB_TMO      128
#define XB_XCNT(j)  (256  + 64 * (j))
#define XB_XSUB(j)  (1280 + 64 * (j))
#define XB_XGEN(j)  (2304 + 64 * (j))
#define XB_TOP      3328
#define XB_TOPGEN   3392
#define XCD_BAR_WORDS 3456
#define XB_SPIN_CAP (1u << 18)

__device__ __forceinline__ unsigned xb_ld(unsigned* p)              { return __hip_atomic_load(p, __ATOMIC_RELAXED, __HIP_MEMORY_SCOPE_AGENT); }
__device__ __forceinline__ unsigned xb_add(unsigned* p, unsigned v) { return __hip_atomic_fetch_add(p, v, __ATOMIC_RELAXED, __HIP_MEMORY_SCOPE_AGENT); }
__device__ __forceinline__ unsigned xb_xcc_id() { return (unsigned)__builtin_amdgcn_s_getreg((3 << 11) | 20) & 0xFu; }
#define XB_SPIN(cond, bar) do { unsigned _sp = 0; while (cond) { __builtin_amdgcn_s_sleep(1); \
    if ((++_sp & 255u) == 0u) { if (xb_ld(&(bar)[XB_TMO])) break; if (_sp > XB_SPIN_CAP) { atomicAdd(&(bar)[XB_TMO], 1u); break; } } } } while (0)

struct XcdBarrier {
    unsigned* bar; unsigned x;
    volatile LAS unsigned* st;
};

__device__ __forceinline__ XcdBarrier xcd_barrier_post(unsigned* bar, volatile LAS unsigned* st) {
    XcdBarrier b; b.bar = bar; b.x = xb_xcc_id(); b.st = st;
    if (threadIdx.x == 0) (void)xb_add(&bar[XB_XCNT(b.x)], 1u);
    return b;
}
__device__ __forceinline__ void xcd_barrier_complete(unsigned* bar, unsigned x, unsigned& nloc, unsigned& nx) {
    const unsigned G = gridDim.x * gridDim.y * gridDim.z;
    unsigned sum, cnt, mine, sp = 0u;
    for (;;) {
        sum = 0u; cnt = 0u; mine = 0u;
#pragma unroll
        for (unsigned j = 0; j < 16; ++j) { const unsigned c = xb_ld(&bar[XB_XCNT(j)]); sum += c; cnt += (c > 0u) ? 1u : 0u; mine = (j == x) ? c : mine; }
        if (sum == G) break;
        __builtin_amdgcn_s_sleep(1);
        if ((++sp & 255u) == 0u) { if (xb_ld(&bar[XB_TMO])) break; if (sp > XB_SPIN_CAP) { atomicAdd(&bar[XB_TMO], 1u); break; } }
    }
    nloc = mine > 0u ? mine : 1u; nx = cnt > 0u ? cnt : 1u;
}

__device__ __forceinline__ void xcd_barrier(const XcdBarrier& b) {
    asm volatile("s_waitcnt vmcnt(0)" ::: "memory");
    __syncthreads();
    if (threadIdx.x == 0) {
        unsigned* bar = b.bar;
        __builtin_amdgcn_s_waitcnt(0);
        unsigned nloc = b.st[0], nx = b.st[1];
        if (nloc == 0u) { xcd_barrier_complete(bar, b.x, nloc, nx); b.st[0] = nloc; b.st[1] = nx; }
        const unsigned old = xb_add(&bar[XB_XSUB(b.x)], 1u);
        const unsigned gen = old / nloc;
        if (old + 1u == (gen + 1u) * nloc) {
            __builtin_amdgcn_fence(__ATOMIC_RELEASE, "agent");
            asm volatile("s_waitcnt vmcnt(0)" ::: "memory");
            const unsigned og = xb_add(&bar[XB_TOP], 1u);
            const unsigned tg = og / nx;
            if (og + 1u == (tg + 1u) * nx) xb_add(&bar[XB_TOPGEN], 1u);
            else XB_SPIN(xb_ld(&bar[XB_TOPGEN]) == tg, bar);
            __builtin_amdgcn_fence(__ATOMIC_ACQUIRE, "agent");
            xb_add(&bar[XB_XGEN(b.x)], 1u);
            asm volatile("s_waitcnt vmcnt(0)" ::: "memory");
        } else {
            XB_SPIN(xb_ld(&bar[XB_XGEN(b.x)]) == gen, bar);
            __builtin_amdgcn_fence(__ATOMIC_ACQUIRE, "agent");
            asm volatile("s_waitcnt vmcnt(0)" ::: "memory");
        }
    }
    __syncthreads();
}

struct Args { P p; int ph_lo, ph_hi; };
constexpr int NPH = 10;
__global__ void __launch_bounds__(512, 2) mk_fwd(Args args) {
    extern __shared__ __attribute__((aligned(16))) unsigned char lds_raw[];
    LAS unsigned char* lds = (LAS unsigned char*)lds_raw;
    const P& p = args.p;
    const int tid = threadIdx.x, lane = tid & 63, wave = __builtin_amdgcn_readfirstlane(tid >> 6);
    const int G = gridDim.x, bx = blockIdx.x;
    const int vb = (G % 8 == 0) ? (bx % 8) * (G / 8) + bx / 8 : bx;
    unsigned char* ws = p.ws;
    const int lo = args.ph_lo, hi = args.ph_hi;
#define IN(k) (lo <= (k) && (k) < hi)
    volatile LAS unsigned* bst = (volatile LAS unsigned*)(lds + 131072 + 64);
    if (tid < 2) bst[tid] = 0u;
    __syncthreads();
    XcdBarrier bar; bar.bar = (unsigned*)(ws + CTL_BAR); bar.x = 0; bar.st = nullptr;
    if (hi - lo > 1) bar = xcd_barrier_post((unsigned*)(ws + CTL_BAR), bst);
#define SEAM(k) do { if (IN(k) && IN((k) + 1)) { xcd_barrier(bar); } } while (0)
    bf16_t* XN = (bf16_t*)(ws + WS_XN);
    float* ssq2 = (float*)(ws + CTL_SSQ2); float* ssq3 = (float*)(ws + CTL_SSQ3);

    if (hi > NPH) cg::this_grid().sync();
    if (IN(0)) { p0_prologue(p, lds, vb, G, wave, lane); }
    SEAM(0);
    if (IN(1)) {
        pg8::Gemm g{XN, (const bf16_t*)(ws + WS_WIN), MT, DIN, 1024, 1024}; pg8::StaticOrder S; S.init(MP, DIN, G, bx); pg8::PanelOrder S2; S2.init(NPAN - 1, DIN, G, (bx + 128) % G);
        EpiIn E{(bf16_t*)(ws + WS_U), (bf16_t*)(ws + WS_Q), (bf16_t*)(ws + WS_KB), (bf16_t*)(ws + WS_VT), (bf16_t*)(ws + WS_SG), (bf16_t*)(ws + WS_SA), p.out};
        pg8::gemm_phase<EpiIn, pg8::StaticOrder, true, true>(lds, g, S, E);
        pg8::gemm_phase<EpiIn, pg8::PanelOrder, true, true, true>(lds, g, S2, E);
    }
    SEAM(1);
    if (IN(2)) {
        LAS float* btab = (LAS float*)(lds + LDS_BT);
        for (int i = tid; i < 8 * 257; i += 512) btab[i] = (p.in[18][i] - p.in[18][(i / 257) * 257 + 256]) * LOG2E;
        __syncthreads();
        unsigned* qctr = (unsigned*)(ws + WS_CTL);
        constexpr int T_S5P = 256, T_S5S = 128, T_ATT = NB * 32 * 8, T_ATS = SBT * 8 * STT;
        constexpr int T_TOTAL = T_S5P + T_S5S + T_ATT + T_ATS;
        for (int bt = bx; bt < T_S5P; bt += G) { int ln = lane; asm volatile("" : "+v"(ln)); s5_prefix_task(p, lds + wave * SW_BYTES, bt, 7 - wave, ln); }
        for (;;) {
            int task = 0;
            if (lane == 0) task = (int)atomicAdd(qctr, 1u) + T_S5P;
            task = __builtin_amdgcn_readfirstlane(task);
            if (task >= T_TOTAL) break;
            int ln = lane; asm volatile("" : "+v"(ln));
            if (task < T_S5P + T_ATS) attn_sample_task(p, btab, (LAS float*)(lds + wave * SW_BYTES), task - T_S5P, ln);
            else if (task < T_S5P + T_ATS + T_S5S) s5_sample_task(p, lds + wave * SW_BYTES, task - (T_S5P + T_ATS), ln);
            else { const int a = task - (T_S5P + T_ATS + T_S5S); attn_task(p, btab, a >> 8, (a >> 3) & 31, a & 7, ln); }
        }
        __syncthreads();
    }
    SEAM(2);
    if (IN(3)) {
        pg8::Gemm g{(const bf16_t*)(ws + WS_ATT), (const bf16_t*)(ws + WS_WAU), MT, 1024, 512, 512}; pg8::StaticOrder S; S.init(MP, 1024, G, bx); pg8::PanelOrder S2; S2.init(NPAN - 1, 1024, G, (bx + 128) % G);
        EpiAttUp E{(const bf16_t*)(ws + WS_SA), XN};
        pg8::gemm_phase<EpiAttUp, pg8::StaticOrder, true, false>(lds, g, S, E);
        pg8::gemm_phase<EpiAttUp, pg8::PanelOrder, true, true, true>(lds, g, S2, E);
    }
    SEAM(3);
    if (IN(4)) {
        pg8::Gemm g{(const bf16_t*)(ws + WS_YS), (const bf16_t*)(ws + WS_WGLU), MT, 2048, 512, 512}; pg8::StaticOrder S; S.init(MP, 2048, G, bx); pg8::PanelOrder S2; S2.init(NPAN - 1, 2048, G, (bx + 128) % G);
        EpiGlu E{(const bf16_t*)(ws + WS_SG), XN};
        pg8::gemm_phase<EpiGlu, pg8::StaticOrder, true, false>(lds, g, S, E);
        pg8::gemm_phase<EpiGlu, pg8::PanelOrder, true, true, true>(lds, g, S2, E);
    }
    SEAM(4);
    if (IN(5)) {
        pg8::Gemm g{XN, (const bf16_t*)(ws + WS_WO), MT, 1024, 1024, 1024}; pg8::StaticOrder S; S.init(MP, 1024, G, bx); pg8::PanelOrder S2; S2.init(NPAN - 1, 1024, G, (bx + 128) % G);
        EpiRes<true> E{p.in[0], p.in[1], p.out, (bf16_t*)(ws + WS_HB), ssq2};
        pg8::gemm_phase<EpiRes<true>, pg8::StaticOrder, true, true>(lds, g, S, E);
        pg8::gemm_phase<EpiRes<true>, pg8::PanelOrder, true, true, true>(lds, g, S2, E);
    }
    SEAM(5);
    if (IN(6)) {
        pg8::Gemm g{(const bf16_t*)(ws + WS_HB), (const bf16_t*)(ws + WS_WUP), MT, 2 * DFF, 1024, 1024}; pg8::StaticOrder S; S.init(MP, 2 * DFF, G, bx); pg8::PanelOrder S2; S2.init(NPAN - 1, 2 * DFF, G, (bx + 128) % G);
        EpiUp E{(bf16_t*)(ws + WS_G), (float*)(ws + WS_HALO), (float*)(ws + WS_SIDEA), (float*)(ws + WS_SIDEB), ssq2, p.in[23], p.in[24], p.in[6], p.out};
        pg8::gemm_phase<EpiUp, pg8::StaticOrder, true, true>(lds, g, S, E);
        pg8::gemm_phase<EpiUp, pg8::PanelOrder, true, true, true>(lds, g, S2, E);
    }
    SEAM(6);
    if (IN(7)) {
        const float* HALO = (const float*)(ws + WS_HALO); const float* SA_ = (const float*)(ws + WS_SIDEA); const float* SB_ = (const float*)(ws + WS_SIDEB);
        bf16_t* Gp = (bf16_t*)(ws + WS_G); const float* taps = p.in[23]; const float* cbv = p.in[24];
        const int nthr = G * 512, gtid = vb * 512 + tid;
        constexpr int CQ = DFF / 4;
        for (int idx = gtid; idx < 512 * 2 * CQ; idx += nthr) {
            const int c = (idx % CQ) * 4, bi = idx / CQ, i = bi & 1, blk = bi >> 1;
            const f32x4 ac = *(const f32x4*)(SA_ + ((size_t)blk * 2 + i) * DFF + c), bv = *(const f32x4*)(SB_ + ((size_t)blk * 2 + i) * DFF + c);
            f32x4 a1 = {0.f, 0.f, 0.f, 0.f}, a2 = {0.f, 0.f, 0.f, 0.f};
            const bool first = (blk & 31) == 0;
            if (i == 1) { a1 = *(const f32x4*)(SA_ + ((size_t)blk * 2) * DFF + c); if (!first) a2 = *(const f32x4*)(HALO + ((size_t)(blk - 1) * 2 + 1) * DFF + c); }
            else if (!first) { a1 = *(const f32x4*)(HALO + ((size_t)(blk - 1) * 2 + 1) * DFF + c); a2 = *(const f32x4*)(HALO + ((size_t)(blk - 1) * 2) * DFF + c); }
            const f32x4 t0 = *(const f32x4*)(taps + c), t1 = *(const f32x4*)(taps + DFF + c), t2 = *(const f32x4*)(taps + 2 * DFF + c), cb = *(const f32x4*)(cbv + c);
            f32x4 g;
#pragma unroll
            for (int e = 0; e < 4; ++e) g[e] = gelu_t(cb[e] + t0[e] * a2[e] + t1[e] * a1[e] + t2[e] * ac[e]) * bv[e];
            u32x2 w; w.x = cvt_pk_bf16(g[0], g[1]); w.y = cvt_pk_bf16(g[2], g[3]);
            *(u32x2*)(Gp + ((size_t)blk * 64 + i) * DFF + c) = w;
        }
        for (int idx = gtid; idx < NB * 2 * CQ; idx += nthr) {
            const int c = (idx % CQ) * 4, bi = idx / CQ, j = bi & 1, nb = bi >> 1;
            *(f32x4*)(p.out + O_CP + ((size_t)nb * 2 + j) * DFF + c) = *(const f32x4*)(HALO + ((size_t)(nb * 32 + 31) * 2 + j) * DFF + c);
        }
    }
    SEAM(7);
    if (IN(8)) {
        pg8::Gemm g{(const bf16_t*)(ws + WS_G), (const bf16_t*)(ws + WS_WDN), MT, 1024, DFF, DFF}; pg8::StaticOrder S; S.init(MP, 1024, G, bx); pg8::PanelOrder S2; S2.init(NPAN - 1, 1024, G, (bx + 128) % G);
        EpiRes<false> E{nullptr, nullptr, p.out, nullptr, ssq3};
        pg8::gemm_phase<EpiRes<false>, pg8::StaticOrder, true, true>(lds, g, S, E);
        { pg8::Gemm gs{(const bf16_t*)(ws + WS_G), (const bf16_t*)(ws + WS_WDN), MT, 1024, 256, DFF}; pg8::PanelOrder S3; S3.init(NPAN - 1, 1024, G, (bx + 128) % G, DFF / 256);
          EpiAddSample E3{p.out};
          pg8::gemm_phase<EpiAddSample, pg8::PanelOrder, true, true, true>(lds, gs, S3, E3); }
    }
    SEAM(8);
    if (IN(9)) {
        const int gw = vb * 8 + wave, NGW = G * 8;
        f32x4 gv[4];
#pragma unroll
        for (int j = 0; j < 4; ++j) gv[j] = *((const f32x4*)p.in[26] + lane + 64 * j);
        for (int m = gw; m < MR; m += NGW) {
            f32x4* r = (f32x4*)hrow(p.out, m) + lane;
            f32x4 v[4]; float s = 0.f;
#pragma unroll
            for (int j = 0; j < 4; ++j) { v[j] = r[64 * j]; s += (v[j].x * v[j].x + v[j].y * v[j].y) + (v[j].z * v[j].z + v[j].w * v[j].w); }
            const float rs = 1.0f / sqrtf(wave_sum(s) * (1.0f / DM) + RMS_EPS);
#pragma unroll
            for (int j = 0; j < 4; ++j) r[64 * j] = v[j] * rs * gv[j];
        }
    }
#undef IN
#undef SEAM
}

extern "C" void kernel_launch(void* const* d_in, const int* in_sizes, int n_in, void* d_out, int out_size, void* d_ws, size_t ws_size, hipStream_t stream) {
    static int grid = 0;
    if (grid == 0) {
        if (n_in != 27 || in_sizes[0] != MP * DM || (size_t)out_size != O_END || ws_size < WS_END) {
            fprintf(stderr, "kernel_launch: unexpected shapes: n_in %d in0 %d out %d ws %zu (need %zu)\n", n_in, n_in > 0 ? in_sizes[0] : -1, out_size, ws_size, (size_t)WS_END); grid = -1; return; }
        int dev = 0, cus = 0, per_cu = 0;
        hipGetDevice(&dev); hipDeviceGetAttribute(&cus, hipDeviceAttributeMultiprocessorCount, dev);
        if (hipFuncSetAttribute((const void*)mk_fwd, hipFuncAttributeMaxDynamicSharedMemorySize, LDS_BYTES) != hipSuccess) { fprintf(stderr, "kernel_launch: hipFuncSetAttribute failed\n"); grid = -1; return; }
        if (hipOccupancyMaxActiveBlocksPerMultiprocessor(&per_cu, (const void*)mk_fwd, 512, LDS_BYTES) != hipSuccess || per_cu < 1) { fprintf(stderr, "kernel_launch: occupancy query says %d\n", per_cu); per_cu = 1; }
        (void)hipGetLastError();
        grid = cus;
    }
    if (grid < 0) return;
    hipMemsetAsync((char*)d_ws + WS_CTL, 0, CTL_BYTES, stream);
    Args a{};
    for (int i = 0; i < 27; ++i) a.p.in[i] = (const float*)d_in[i];
    a.p.out = (float*)d_out; a.p.ws = (unsigned char*)d_ws;
#if MK_N_LAUNCHES == 1
    a.ph_lo = 0; a.ph_hi = NPH;
    void* kargs[] = {&a};
    hipError_t e = hipLaunchCooperativeKernel((const void*)mk_fwd, dim3(grid), dim3(512), kargs, LDS_BYTES, stream);
    if (e != hipSuccess) fprintf(stderr, "kernel_launch: cooperative launch failed: %s (grid %d)\n", hipGetErrorString(e), grid);
#else
    for (int ph = 0; ph < NPH; ++ph) { a.ph_lo = ph; a.ph_hi = ph + 1; hipLaunchKernelGGL(mk_fwd, dim3(grid), dim3(512), LDS_BYTES, stream, a); }
#endif
}
```
